# Optimizing an MI355X kernel written in HIP

```python
import math
import jax, jax.numpy as jnp
from jax import lax
import numpy as np

D_MODEL = 1024
BATCH = 16
SEQ = 4096
DEPTH = 4

GRID_W = 64
CTX_LEN = 256
HEAD_DIM = 64
N_Q_HEADS = D_MODEL // (2 * HEAD_DIM)
N_KV_HEADS = max(1, N_Q_HEADS // 4)
GQA_GROUP = N_Q_HEADS // N_KV_HEADS
Q_W = N_Q_HEADS * HEAD_DIM
KV_W = N_KV_HEADS * HEAD_DIM
RNN_W = D_MODEL // 2
RNN_BLOCKS = RNN_W // HEAD_DIM
RNN_BW = RNN_W // RNN_BLOCKS
IN_W = Q_W + 2 * KV_W + 2 * RNN_W
MIX_W = Q_W + RNN_W
CONV_K = 4
CONV_LEFT = 2
RG_C = 8.0
ROPE_THETA = 10000.0
Q_BLOCK = 128
RWKV_HEADS = D_MODEL // HEAD_DIM
RWKV_LORA = 64
RWKV_GATE_LORA = 128
DECAY_SCALE = math.exp(-0.5)
GN_EPS = 64e-5
D_FF = 4 * D_MODEL
N_EVEN = (DEPTH + 1) // 2
N_ODD = DEPTH // 2
EPS = 1e-6
F32 = jnp.float32

kernel_name = "hybrid_rglru_gqa_rwkv7_dit_prefix"


def rmsnorm(x, g):
    xf = x.astype(F32)
    y = xf * lax.rsqrt(jnp.mean(xf * xf, axis=-1, keepdims=True) + EPS)
    return (y * g.astype(F32)).astype(x.dtype)


def ada_chunks(cvec, w_mod, b_mod):
    m = jnp.dot(jax.nn.silu(cvec), w_mod) + b_mod
    return jnp.split(m, 6, axis=-1)


def axial_rope(n):
    rows = n // GRID_W
    row = jnp.repeat(jnp.arange(rows, dtype=F32), GRID_W)
    col = jnp.tile(jnp.arange(GRID_W, dtype=F32), rows)
    half = HEAD_DIM // 2
    inv = ROPE_THETA ** (-jnp.arange(0, half, 2, dtype=F32) / half)
    ang = jnp.concatenate([row[:, None] * inv, col[:, None] * inv], axis=-1)
    return jnp.cos(ang), jnp.sin(ang)


def apply_rope(x, cos, sin):
    x1 = x[..., 0::2].astype(F32)
    x2 = x[..., 1::2].astype(F32)
    y = jnp.stack([x1 * cos - x2 * sin, x1 * sin + x2 * cos], axis=-1)
    return y.reshape(x.shape).astype(x.dtype)


def attend(q, k, v):
    s = jnp.einsum('bqhgd,bkhd->bhgqk', q, k).astype(F32) * HEAD_DIM ** -0.5
    p = jax.nn.softmax(s, axis=-1).astype(v.dtype)
    return jnp.einsum('bhgqk,bkhd->bqhgd', p, v)


def blocked_attend(q, k, v):
    b, n = q.shape[0], q.shape[1]
    nb = n // Q_BLOCK
    qb = jnp.moveaxis(q.reshape(b, nb, Q_BLOCK, N_KV_HEADS, GQA_GROUP, HEAD_DIM), 1, 0)
    o = lax.map(lambda qi: attend(qi, k, v), qb)
    return jnp.moveaxis(o, 0, 1).reshape(b, n, Q_W)


def dwconv(x, w, bias):
    t = x.shape[1]
    xp = jnp.pad(x, ((0, 0), (CONV_LEFT, CONV_K - 1 - CONV_LEFT), (0, 0)))
    out = bias
    for j in range(CONV_K):
        out = out + xp[:, j:j + t] * w[j]
    return out


def rglru_coeffs(x, w, bias, lam):
    xf = x.astype(F32)
    xb = xf.reshape(xf.shape[0], xf.shape[1], RNN_BLOCKS, RNN_BW)
    gates = jnp.einsum('btnd,gnde->gbtne', xb, w.astype(F32)).reshape((2,) + xf.shape)
    gates = gates + bias.astype(F32)[:, None, None, :]
    r = jax.nn.sigmoid(gates[0])
    i = jax.nn.sigmoid(gates[1])
    log_a = -RG_C * r * jax.nn.softplus(-lam.astype(F32))
    a = jnp.exp(log_a)
    u = jnp.sqrt(-jnp.expm1(2.0 * log_a)) * (i * xf)
    return a, u


def linear_scan(a, u, h0, reverse):
    if h0 is not None:
        idx = -1 if reverse else 0
        u = u.at[:, idx].add(a[:, idx] * h0)

    def comb(l, r):
        return l[0] * r[0], r[0] * l[1] + r[1]

    _, h = lax.associative_scan(comb, (a, u), reverse=reverse, axis=1)
    return h


def hybrid_mixer(hl, hc, w_in, w_out, q_norm, k_norm, conv_w, conv_b, gate_w, gate_b, lam, cos, sin, need_ctx):
    b, n, _ = hl.shape
    cl = hc.shape[1]
    cuts = [Q_W, Q_W + KV_W, Q_W + 2 * KV_W, Q_W + 2 * KV_W + RNN_W]
    ql, kl, vl, xl, gl = jnp.split(hl @ w_in, cuts, axis=-1)
    qc, kc, vc, xc, gc = jnp.split(hc @ w_in, cuts, axis=-1)
    qlh = apply_rope(rmsnorm(ql.reshape(b, n, N_KV_HEADS, GQA_GROUP, HEAD_DIM), q_norm),
                     cos[None, :, None, None, :], sin[None, :, None, None, :])
    klh = apply_rope(rmsnorm(kl.reshape(b, n, N_KV_HEADS, HEAD_DIM), k_norm),
                     cos[None, :, None, :], sin[None, :, None, :])
    kch = rmsnorm(kc.reshape(b, cl, N_KV_HEADS, HEAD_DIM), k_norm)
    vch = vc.reshape(b, cl, N_KV_HEADS, HEAD_DIM)
    k_all = jnp.concatenate([kch, klh], axis=1)
    v_all = jnp.concatenate([vch, vl.reshape(b, n, N_KV_HEADS, HEAD_DIM)], axis=1)
    att_l = blocked_attend(qlh, k_all, v_all)
    xl = dwconv(xl, conv_w, conv_b)
    xc = dwconv(xc, conv_w, conv_b)
    h_lat, h_ctx = [], []
    for d, rev in enumerate((False, True)):
        a_c, u_c = rglru_coeffs(xc, gate_w[d], gate_b[d], lam[d])
        hcd = linear_scan(a_c, u_c, None, rev)
        h0 = hcd[:, 0] if rev else hcd[:, -1]
        a_l, u_l = rglru_coeffs(xl, gate_w[d], gate_b[d], lam[d])
        h_lat.append(linear_scan(a_l, u_l, h0, rev))
        h_ctx.append(hcd)
    rec_l = (jax.nn.gelu(gl.astype(F32)) * (h_lat[0] + h_lat[1])).astype(hl.dtype)
    out_l = jnp.concatenate([att_l, rec_l], axis=-1) @ w_out
    out_c = None
    if need_ctx:
        qch = rmsnorm(qc.reshape(b, cl, N_KV_HEADS, GQA_GROUP, HEAD_DIM), q_norm)
        att_c = attend(qch, kch, vch).reshape(b, cl, Q_W)
        rec_c = (jax.nn.gelu(gc.astype(F32)) * (h_ctx[0] + h_ctx[1])).astype(hc.dtype)
        out_c = jnp.concatenate([att_c, rec_c], axis=-1) @ w_out
    return out_l, out_c


def rwkv7_project(h, mu, w_rkv, lora_down, lora_up, lora_bias, gate_down, gate_up, k_k, k_a):
    b, t, _ = h.shape
    hp = jnp.pad(h, ((0, 0), (1, 1), (0, 0)))
    xx = 0.5 * (hp[:, :-2] + hp[:, 2:]) - h
    lerp = lambda j: h + xx * mu[j]
    heads = lambda z: z.astype(F32).reshape(b, t, RWKV_HEADS, HEAD_DIM)
    r = heads(lerp(0) @ w_rkv[0])
    k = heads(lerp(2) @ w_rkv[1])
    v = heads(lerp(3) @ w_rkv[2])
    g = jax.nn.sigmoid(lerp(5) @ gate_down) @ gate_up
    kk = k * k_k.astype(F32).reshape(RWKV_HEADS, HEAD_DIM)
    kk = kk / jnp.maximum(jnp.sqrt(jnp.sum(kk * kk, axis=-1, keepdims=True)), 1e-12)
    k_a_h = k_a.astype(F32).reshape(RWKV_HEADS, HEAD_DIM)
    xw, xa = lerp(1), lerp(4)
    dirs = []
    for d in range(2):
        dec = heads(lora_bias[d, 0] + jnp.tanh(xw @ lora_down[d, 0]) @ lora_up[d, 0])
        w = jnp.exp(-DECAY_SCALE * jax.nn.sigmoid(dec))
        a = jax.nn.sigmoid(heads(lora_bias[d, 1] + (xa @ lora_down[d, 1]) @ lora_up[d, 1]))
        kd = k * (1.0 + (a - 1.0) * k_a_h)
        dirs.append((w, kk * a, kd))
    return r, kk, v, g, dirs


def wkv_scan(r, w, kk, bvec, k, v, s0, reverse):
    def step(s, inp):
        r_t, w_t, kk_t, b_t, k_t, v_t = inp
        sk = jnp.einsum('bhvk,bhk->bhv', s, kk_t)
        s = s * w_t[:, :, None, :] - sk[..., None] * b_t[:, :, None, :] + v_t[..., None] * k_t[:, :, None, :]
        return s, jnp.einsum('bhvk,bhk->bhv', s, r_t)

    xs = tuple(jnp.moveaxis(z, 1, 0) for z in (r, w, kk, bvec, k, v))
    s_fin, y = lax.scan(step, s0, xs, reverse=reverse)
    return s_fin, jnp.moveaxis(y, 0, 1)


def rwkv7_out(y, r, v, kds, g, r_k, gn_g, gn_b, w_o):
    b, t = y.shape[0], y.shape[1]
    mean = jnp.mean(y, axis=-1, keepdims=True)
    var = jnp.mean(jnp.square(y - mean), axis=-1, keepdims=True)
    yn = ((y - mean) * lax.rsqrt(var + GN_EPS)).reshape(b, t, D_MODEL)
    rk = r_k.astype(F32)
    bonus = sum(jnp.sum(r * kd * rk, axis=-1, keepdims=True) for kd in kds) * v
    o = (yn * gn_g.astype(F32) + gn_b.astype(F32) + bonus.reshape(b, t, D_MODEL)) * g
    return o.astype(g.dtype) @ w_o


def rwkv7_mixer(hl, hc, mu, w_rkv, w_o, lora_down, lora_up, lora_bias, gate_down, gate_up,
                k_k, k_a, r_k, gn_g, gn_b, need_ctx):
    proj = lambda h: rwkv7_project(h, mu, w_rkv, lora_down, lora_up, lora_bias, gate_down, gate_up, k_k, k_a)
    rl, kkl, vl, gl, dl = proj(hl)
    rc, kkc, vc, gc, dc = proj(hc)
    s0 = jnp.zeros((hl.shape[0], RWKV_HEADS, HEAD_DIM, HEAD_DIM), F32)
    ys_l, ys_c = [], []
    for d, rev in enumerate((False, True)):
        s_c, y_c = wkv_scan(rc, dc[d][0], kkc, dc[d][1], dc[d][2], vc, s0, rev)
        _, y_l = wkv_scan(rl, dl[d][0], kkl, dl[d][1], dl[d][2], vl, s_c, rev)
        ys_l.append(y_l)
        ys_c.append(y_c)
    out_l = rwkv7_out(ys_l[0] + ys_l[1], rl, vl, [dl[0][2], dl[1][2]], gl, r_k, gn_g, gn_b, w_o)
    out_c = None
    if need_ctx:
        out_c = rwkv7_out(ys_c[0] + ys_c[1], rc, vc, [dc[0][2], dc[1][2]], gc, r_k, gn_g, gn_b, w_o)
    return out_l, out_c


def sqrelu_mlp(h, w1, w2):
    return jnp.square(jax.nn.relu(h @ w1)) @ w2


def setup_inputs(seed: int = 0) -> dict:
    key = jax.random.key(seed)
    ks = iter(jax.random.split(key, 40))
    nrm = lambda shape, scale: scale * jax.random.normal(next(ks), shape, F32)
    uni = lambda shape, lo, hi: jax.random.uniform(next(ks), shape, F32, lo, hi)
    D = D_MODEL
    x = nrm((BATCH, SEQ, D), 1.0)
    c = nrm((BATCH, D), 1.0)
    ctx = nrm((BATCH, CTX_LEN, D), 1.0)
    c_ctx = nrm((D,), 1.0)
    ada_w = nrm((DEPTH, D, 6 * D), 0.5 * D ** -0.5)
    ada_b = nrm((DEPTH, 6 * D), 0.02)
    norm_g = 1.0 + nrm((DEPTH, 2, D), 0.05)
    mlp_w1 = nrm((DEPTH, D, D_FF), D ** -0.5)
    mlp_w2 = nrm((DEPTH, D_FF, D), D_FF ** -0.5)
    hy_w_in = nrm((N_EVEN, D, IN_W), D ** -0.5)
    hy_w_out = nrm((N_EVEN, MIX_W, D), MIX_W ** -0.5)
    hy_q_norm = 1.0 + nrm((N_EVEN, HEAD_DIM), 0.05)
    hy_k_norm = 1.0 + nrm((N_EVEN, HEAD_DIM), 0.05)
    hy_conv_w = nrm((N_EVEN, CONV_K, RNN_W), CONV_K ** -0.5)
    hy_conv_b = nrm((N_EVEN, RNN_W), 0.02)
    hy_gate_w = nrm((N_EVEN, 2, 2, RNN_BLOCKS, RNN_BW, RNN_BW), RNN_BW ** -0.5)
    hy_gate_b = nrm((N_EVEN, 2, 2, RNN_W), 0.1)
    s = uni((N_EVEN, 2, RNN_W), 0.9, 0.999) ** (1.0 / RG_C)
    hy_lam = jnp.log(s) - jnp.log1p(-s)
    rw_mu = uni((N_ODD, 6, D), 0.0, 1.0)
    rw_w_rkv = nrm((N_ODD, 3, D, D), D ** -0.5)
    rw_w_o = nrm((N_ODD, D, D), D ** -0.5)
    rw_lora_down = nrm((N_ODD, 2, 2, D, RWKV_LORA), D ** -0.5)
    rw_lora_up = nrm((N_ODD, 2, 2, RWKV_LORA, D), 0.1 * RWKV_LORA ** -0.5)
    w0 = uni((N_ODD, 2, D), -6.0, -0.5)
    a0 = nrm((N_ODD, 2, D), 0.1)
    rw_lora_bias = jnp.stack([w0, a0], axis=2)
    rw_gate_down = nrm((N_ODD, D, RWKV_GATE_LORA), D ** -0.5)
    rw_gate_up = nrm((N_ODD, RWKV_GATE_LORA, D), RWKV_GATE_LORA ** -0.5)
    rw_k_k = 0.85 + nrm((N_ODD, D), 0.05)
    rw_k_a = 1.0 + nrm((N_ODD, D), 0.05)
    rw_r_k = nrm((N_ODD, RWKV_HEADS, HEAD_DIM), 0.1)
    rw_gn_g = 1.0 + nrm((N_ODD, D), 0.05)
    rw_gn_b = nrm((N_ODD, D), 0.02)
    return {"x": x, "c": c, "ctx": ctx, "c_ctx": c_ctx,
            "ada_w": ada_w, "ada_b": ada_b, "norm_g": norm_g, "mlp_w1": mlp_w1, "mlp_w2": mlp_w2,
            "hy_w_in": hy_w_in, "hy_w_out": hy_w_out, "hy_q_norm": hy_q_norm, "hy_k_norm": hy_k_norm,
            "hy_conv_w": hy_conv_w, "hy_conv_b": hy_conv_b, "hy_gate_w": hy_gate_w, "hy_gate_b": hy_gate_b,
            "hy_lam": hy_lam,
            "rw_mu": rw_mu, "rw_w_rkv": rw_w_rkv, "rw_w_o": rw_w_o, "rw_lora_down": rw_lora_down,
            "rw_lora_up": rw_lora_up, "rw_lora_bias": rw_lora_bias, "rw_gate_down": rw_gate_down,
            "rw_gate_up": rw_gate_up, "rw_k_k": rw_k_k, "rw_k_a": rw_k_a, "rw_r_k": rw_r_k,
            "rw_gn_g": rw_gn_g, "rw_gn_b": rw_gn_b}


def reference(x, c, ctx, c_ctx, ada_w, ada_b, norm_g, mlp_w1, mlp_w2,
              hy_w_in, hy_w_out, hy_q_norm, hy_k_norm, hy_conv_w, hy_conv_b, hy_gate_w, hy_gate_b, hy_lam,
              rw_mu, rw_w_rkv, rw_w_o, rw_lora_down, rw_lora_up, rw_lora_bias, rw_gate_down, rw_gate_up,
              rw_k_k, rw_k_a, rw_r_k, rw_gn_g, rw_gn_b):
    cos, sin = axial_rope(x.shape[1])
    for l in range(DEPTH):
        i = l // 2
        need_ctx = l < DEPTH - 1
        ml = [m[:, None, :] for m in ada_chunks(c, ada_w[l], ada_b[l])]
        mc = ada_chunks(c_ctx, ada_w[l], ada_b[l])
        hl = rmsnorm(x, norm_g[l, 0]) * (1.0 + ml[1]) + ml[0]
        hc = rmsnorm(ctx, norm_g[l, 0]) * (1.0 + mc[1]) + mc[0]
        if l % 2 == 0:
            ol, oc = hybrid_mixer(hl, hc, hy_w_in[i], hy_w_out[i], hy_q_norm[i], hy_k_norm[i],
                                  hy_conv_w[i], hy_conv_b[i], hy_gate_w[i], hy_gate_b[i], hy_lam[i],
                                  cos, sin, need_ctx)
        else:
            ol, oc = rwkv7_mixer(hl, hc, rw_mu[i], rw_w_rkv[i], rw_w_o[i], rw_lora_down[i], rw_lora_up[i],
                                 rw_lora_bias[i], rw_gate_down[i], rw_gate_up[i], rw_k_k[i], rw_k_a[i],
                                 rw_r_k[i], rw_gn_g[i], rw_gn_b[i], need_ctx)
        x = x + ml[2] * ol
        x = x + ml[5] * sqrelu_mlp(rmsnorm(x, norm_g[l, 1]) * (1.0 + ml[4]) + ml[3], mlp_w1[l], mlp_w2[l])
        if need_ctx:
            ctx = ctx + mc[2] * oc
            ctx = ctx + mc[5] * sqrelu_mlp(rmsnorm(ctx, norm_g[l, 1]) * (1.0 + mc[4]) + mc[3], mlp_w1[l], mlp_w2[l])
    return x
```

```cpp
#include <hip/hip_runtime.h>
#include <hip/hip_cooperative_groups.h>
#include <hip/hip_bf16.h>
#include <cstdio>
#include <cstdint>
#include <cmath>
namespace cg = cooperative_groups;
namespace pg8 {
#define PG8_LAS __attribute__((address_space(3)))
typedef unsigned short bf16_t;
typedef short bf16x8 __attribute__((ext_vector_type(8)));
typedef float f32x4 __attribute__((ext_vector_type(4)));
typedef unsigned u32x4 __attribute__((ext_vector_type(4)));
constexpr int BM = 256, BK = 64, HALF = 128, HTB = HALF * BK * 2  , STAGE_BYTES = 8 * HTB, NXCD = 8, WGM = 8;

__host__ __device__ __forceinline__ int lds_byte(int r, int c) { const int st = (r >> 4) * 2 + (c >> 5), rr = r & 15, cc = c & 31, ob = rr * 64 + cc * 2; return st * 1024 + (ob ^ (((ob >> 9) & 1) << 5)); }
__host__ __device__ __forceinline__ void stage_rc(int b, int& R, int& C) { const int st = b / 1024, sb = b % 1024, swz = sb ^ (((sb >> 9) & 1) << 5); R = (st >> 1) * 16 + swz / 64; C = (st & 1) * 32 + (swz % 64) / 2; }
__host__ __device__ __forceinline__ int perm32(int rho) { const int n = rho >> 4, i = rho & 15; return 8 * (i >> 2) + 4 * n + (i & 3); }

struct Unit { int pm, pn; };
struct Gemm { const bf16_t* A; const bf16_t* Bt; int M, N, K, lda; };

struct StaticOrder {
    int nM, nN, nwg, G, c;
    __host__ __device__ void init(int M, int N, int G_, int c_) { nM = M / BM; nN = N / BM; nwg = nM * nN; G = G_; c = c_; }
    __host__ __device__ bool next(int i, Unit& u) const {
        const long L = (long)i * G + c; if (L >= nwg) return false;
        int wgid = (int)L; { const int q = nwg / NXCD, r = nwg % NXCD, xcd = wgid % NXCD, off = wgid / NXCD; wgid = (xcd < r ? xcd * (q + 1) : r * (q + 1) + (xcd - r) * q) + off; }
        const int nig = WGM * nN, gid = wgid / nig, fm = gid * WGM, gsz = (nM - fm) < WGM ? (nM - fm) : WGM;
        u.pm = fm + ((wgid % nig) % gsz); u.pn = (wgid % nig) / gsz; return true;
    }
    __device__ __forceinline__ void a_ready(const Unit&) const {}
    __device__ __forceinline__ void done(const Unit&) const {}
};

}
namespace pg8 {
__device__ __forceinline__ unsigned cvt_pk_bf16(float lo, float hi) { unsigned r; asm("v_cvt_pk_bf16_f32 %0, %1, %2" : "=v"(r) : "v"(lo), "v"(hi)); return r; }
__device__ __forceinline__ float sigm(float x) { return 1.0f / (1.0f + __expf(-x)); }
template <int MODE> struct EpiStore {
    static constexpr bool PERM = true, AFTER_DRAIN = false;
    bf16_t* O; int ldc; bf16_t* O2;
    __device__ __forceinline__ void operator()(const f32x4 (&acc)[2][2][4][2], const Unit& u, int wr, int wc, int fr, int fq) const {
        const int row0 = u.pm * BM + wr * 64 + fr;
#pragma unroll
        for (int bj = 0; bj < 2; ++bj) {
            const int colb = u.pn * BM + bj * HALF;
            int c0 = colb + wc * 32 + 8 * fq; bf16_t* base = O; int ld = ldc; int act = 0;
            if (MODE == 2 && colb >= 3072) { base = O2; ld = 512; c0 -= 3072; const int g = (colb - 3072) >> 7; act = (g == 0) ? 1 : (g == 2 ? 2 : 0); }
#pragma unroll
            for (int ai = 0; ai < 2; ++ai)
#pragma unroll
                for (int m = 0; m < 4; ++m) {
                    f32x4 v0 = acc[ai][bj][m][0], v1 = acc[ai][bj][m][1];
                    if (MODE == 1) {
#pragma unroll
                        for (int e = 0; e < 4; ++e) { float a = fmaxf(v0[e], 0.f), b = fmaxf(v1[e], 0.f); v0[e] = a * a; v1[e] = b * b; }
                    }
                    if (MODE == 2) {
                        if (act == 1) {
#pragma unroll
                            for (int e = 0; e < 4; ++e) { v0[e] = tanhf(v0[e]); v1[e] = tanhf(v1[e]); }
                        } else if (act == 2) {
#pragma unroll
                            for (int e = 0; e < 4; ++e) { v0[e] = sigm(v0[e]); v1[e] = sigm(v1[e]); }
                        }
                    }
                    u32x4 w; w.x = cvt_pk_bf16(v0[0], v0[1]); w.y = cvt_pk_bf16(v0[2], v0[3]); w.z = cvt_pk_bf16(v1[0], v1[1]); w.w = cvt_pk_bf16(v1[2], v1[3]);
                    *(u32x4*)(base + (size_t)(row0 + ai * HALF + m * 16) * ld + c0) = w;
                }
        }
    }
};
struct EpiResid {
    static constexpr bool PERM = true, AFTER_DRAIN = false;
    const float* xin_l; const float* xin_c; float* xo_l; float* xo_c; const float* gate;
    __device__ __forceinline__ void operator()(const f32x4 (&acc)[2][2][4][2], const Unit& u, int wr, int wc, int fr, int fq) const {
        const int pmrow = u.pm * BM; const bool lat = pmrow < 65536;
        const float* xi = lat ? xin_l + (size_t)pmrow * 1024 : xin_c + (size_t)(pmrow - 65536) * 1024;
        float* xo = lat ? xo_l + (size_t)pmrow * 1024 : xo_c + (size_t)(pmrow - 65536) * 1024;
        const float* gv = gate + (size_t)(lat ? (pmrow >> 12) : 16) * 6144;
#pragma unroll
        for (int bj = 0; bj < 2; ++bj) {
            const int c0 = u.pn * BM + bj * HALF + wc * 32 + 8 * fq;
            const f32x4 g0 = *(const f32x4*)(gv + c0), g1 = *(const f32x4*)(gv + c0 + 4);
#pragma unroll
            for (int ai = 0; ai < 2; ++ai)
#pragma unroll
                for (int m = 0; m < 4; ++m) {
                    const size_t off = (size_t)(wr * 64 + fr + ai * HALF + m * 16) * 1024 + c0;
                    const f32x4 x0 = *(const f32x4*)(xi + off), x1 = *(const f32x4*)(xi + off + 4);
                    *(f32x4*)(xo + off) = x0 + g0 * acc[ai][bj][m][0];
                    *(f32x4*)(xo + off + 4) = x1 + g1 * acc[ai][bj][m][1];
                }
        }
    }
};
struct EpiMulInplace {
    static constexpr bool PERM = true, AFTER_DRAIN = false;
    bf16_t* O;
    __device__ __forceinline__ void operator()(const f32x4 (&acc)[2][2][4][2], const Unit& u, int wr, int wc, int fr, int fq) const {
        const int row0 = u.pm * BM + wr * 64 + fr;
#pragma unroll
        for (int bj = 0; bj < 2; ++bj) {
            const int c0 = u.pn * BM + bj * HALF + wc * 32 + 8 * fq;
#pragma unroll
            for (int ai = 0; ai < 2; ++ai)
#pragma unroll
                for (int m = 0; m < 4; ++m) {
                    bf16_t* p = O + (size_t)(row0 + ai * HALF + m * 16) * 1024 + c0;
                    const u32x4 o = *(const u32x4*)p; const f32x4 a0 = acc[ai][bj][m][0], a1 = acc[ai][bj][m][1];
                    u32x4 w;
                    w.x = cvt_pk_bf16(__uint_as_float(o.x << 16) * a0[0], __uint_as_float(o.x & 0xffff0000u) * a0[1]);
                    w.y = cvt_pk_bf16(__uint_as_float(o.y << 16) * a0[2], __uint_as_float(o.y & 0xffff0000u) * a0[3]);
                    w.z = cvt_pk_bf16(__uint_as_float(o.z << 16) * a1[0], __uint_as_float(o.z & 0xffff0000u) * a1[1]);
                    w.w = cvt_pk_bf16(__uint_as_float(o.w << 16) * a1[2], __uint_as_float(o.w & 0xffff0000u) * a1[3]);
                    *(u32x4*)p = w;
                }
        }
    }
};
}
namespace pg8 {
template <class Epi, class Sched, bool ALIGN_EPI = false, bool SP2 = false>
__device__ __forceinline__ void gemm_phase(PG8_LAS unsigned char* lds, const Gemm g, const Sched& S, const Epi& E) {
    int tid_ = threadIdx.x; asm volatile("" : "+v"(tid_)); const int tid = tid_, wid = __builtin_amdgcn_readfirstlane(tid >> 6), lane = tid & 63, wr = wid >> 2, wc = wid & 3, fr = lane & 15, fq = lane >> 4;
    const int K = g.K, nt = K / BK;
    unsigned voffA[2], voffB[2];
#pragma unroll
    for (int i = 0; i < 2; ++i) { int R, C; stage_rc(tid * 16 + i * 8192, R, C); const int Rb = Epi::PERM ? ((R & ~31) + perm32(R & 31)) : R;
        voffA[i] = (unsigned)(R * g.lda + C) * 2u; voffB[i] = (unsigned)(Rb * K + C) * 2u; }
    const size_t kstep = (size_t)(BK * 2);
    const size_t hstep = (size_t)HALF * K * 2;
    const size_t tstep = 2 * hstep; const size_t hstepA = (size_t)HALF * g.lda * 2, tstepA = 2 * hstepA;
    const unsigned ldsw = (unsigned)wid * 1024u;
    const int aoff = lds_byte(wr * 64 + fr, fq * 8), boff = lds_byte(wc * 32 + fr, fq * 8);
#define PG8_SA(b, h) (((b) * 2 + (h)) * HTB)
#define PG8_SB(b, h) ((4 + (b) * 2 + (h)) * HTB)
#define PG8_STAGE(bufoff, gbase, voff) do { _Pragma("unroll") for (int _i = 0; _i < 2; ++_i) \
        __builtin_amdgcn_global_load_lds((const unsigned*)((const char*)(gbase) + (voff)[_i]), (PG8_LAS unsigned*)(lds + (bufoff) + ldsw + _i * 8192), 16, 0, 0); } while (0)
#define PG8_LDA(dst, b, h) do { _Pragma("unroll") for (int m = 0; m < 4; ++m) _Pragma("unroll") for (int k = 0; k < 2; ++k) dst[m][k] = *(const PG8_LAS bf16x8*)(lds + PG8_SA(b, h) + aoff + m * 2048 + k * 1024); } while (0)
#define PG8_LDB(dst, b, h) do { _Pragma("unroll") for (int n = 0; n < 2; ++n) _Pragma("unroll") for (int k = 0; k < 2; ++k) dst[n][k] = *(const PG8_LAS bf16x8*)(lds + PG8_SB(b, h) + boff + n * 2048 + k * 1024); } while (0)
#define PG8_MMA(ai, bj, At, Bt) do { __builtin_amdgcn_s_setprio(1); _Pragma("unroll") for (int m = 0; m < 4; ++m) _Pragma("unroll") for (int n = 0; n < 2; ++n) _Pragma("unroll") for (int k = 0; k < 2; ++k) \
        acc[ai][bj][m][n] = __builtin_amdgcn_mfma_f32_16x16x32_bf16(Bt[n][k], At[m][k], acc[ai][bj][m][n], 0, 0, 0); __builtin_amdgcn_s_setprio(0); } while (0)
#define PG8_WAIT_V(n) asm volatile("s_waitcnt vmcnt(" #n ")" ::: "memory")
#define PG8_WAIT_L(n) asm volatile("s_waitcnt lgkmcnt(" #n ")" ::: "memory")
#define PG8_BAR __builtin_amdgcn_s_barrier()
#define PG8_SCHED __builtin_amdgcn_sched_barrier(0)
    Unit cur, nxt; int ui = 0;
    if (!S.next(0, cur)) return;
    f32x4 acc[2][2][4][2];
#pragma unroll
    for (int a = 0; a < 2; ++a)
#pragma unroll
        for (int b = 0; b < 2; ++b)
#pragma unroll
            for (int m = 0; m < 4; ++m)
#pragma unroll
                for (int n = 0; n < 2; ++n) acc[a][b][m][n] = (f32x4){0.f, 0.f, 0.f, 0.f};
    bf16x8 At[4][2], B0[2][2], B1[2][2];
    const char* cA = (const char*)g.A + (size_t)cur.pm * tstepA; const char* cB = (const char*)g.Bt + (size_t)cur.pn * tstep;
    S.a_ready(cur);
    if constexpr (SP2) {
        PG8_STAGE(PG8_SB(0, 0), cB, voffB); PG8_STAGE(PG8_SB(0, 1), cB + hstep, voffB); PG8_STAGE(PG8_SA(0, 0), cA, voffA); PG8_STAGE(PG8_SA(0, 1), cA + hstepA, voffA);
        if (wr == 1) PG8_BAR;
        PG8_WAIT_V(2); PG8_BAR;
        PG8_STAGE(PG8_SB(1, 0), cB + kstep, voffB); PG8_STAGE(PG8_SA(1, 0), cA + kstep, voffA); PG8_STAGE(PG8_SB(1, 1), cB + hstep + kstep, voffB);
        PG8_WAIT_V(6); PG8_BAR;
    } else {
        PG8_STAGE(PG8_SB(0, 0), cB, voffB); PG8_STAGE(PG8_SA(0, 0), cA, voffA); PG8_STAGE(PG8_SB(0, 1), cB + hstep, voffB); PG8_STAGE(PG8_SA(0, 1), cA + hstepA, voffA);
        if (wr == 1) PG8_BAR;
        PG8_WAIT_V(4); PG8_BAR;
        PG8_STAGE(PG8_SB(1, 0), cB + kstep, voffB); PG8_STAGE(PG8_SA(1, 0), cA + kstep, voffA); PG8_STAGE(PG8_SB(1, 1), cB + hstep + kstep, voffB);
        PG8_WAIT_V(6); PG8_BAR;
    }
    for (;;) {
        const bool has_next = S.next(ui + 1, nxt);
        const char* nA = has_next ? (const char*)g.A + (size_t)nxt.pm * tstepA : cA; const char* nB = has_next ? (const char*)g.Bt + (size_t)nxt.pn * tstep : cB;
        for (int t = 0; t < nt; t += 2) {
            const bool last = (t == nt - 2);
            const char* a1 = cA + (size_t)(t + 1) * kstep;
            const char* a2 = last ? nA : cA + (size_t)(t + 2) * kstep; const char* b2 = last ? nB : cB + (size_t)(t + 2) * kstep;
            const char* a3 = a2 + kstep; const char* b3 = b2 + kstep;
            if (last && has_next) S.a_ready(nxt);
            if constexpr (SP2) {
            PG8_LDB(B0, 0, 0); PG8_LDB(B1, 0, 1); PG8_SCHED; PG8_LDA(At, 0, 0); PG8_STAGE(PG8_SA(1, 1), a1 + hstepA, voffA);
            PG8_WAIT_V(8); PG8_WAIT_L(0); PG8_BAR; PG8_MMA(0, 0, At, B0); PG8_MMA(0, 1, At, B1); PG8_BAR; PG8_SCHED;
            PG8_LDA(At, 0, 1); PG8_STAGE(PG8_SB(0, 0), b2, voffB); PG8_STAGE(PG8_SB(0, 1), b2 + hstep, voffB); PG8_STAGE(PG8_SA(0, 0), a2, voffA);
            PG8_WAIT_V(8); PG8_WAIT_L(0); PG8_BAR; PG8_MMA(1, 0, At, B0); PG8_MMA(1, 1, At, B1); PG8_BAR; PG8_SCHED;
            PG8_LDB(B0, 1, 0); PG8_LDB(B1, 1, 1); PG8_SCHED; PG8_LDA(At, 1, 0); PG8_STAGE(PG8_SA(0, 1), a2 + hstepA, voffA);
            PG8_WAIT_V(8); PG8_WAIT_L(0); PG8_BAR; PG8_MMA(0, 0, At, B0); PG8_MMA(0, 1, At, B1); PG8_BAR; PG8_SCHED;
            PG8_LDA(At, 1, 1); PG8_STAGE(PG8_SB(1, 0), b3, voffB); PG8_STAGE(PG8_SB(1, 1), b3 + hstep, voffB); PG8_STAGE(PG8_SA(1, 0), a3, voffA);
            PG8_WAIT_V(8); PG8_WAIT_L(0); PG8_BAR; PG8_MMA(1, 0, At, B0); PG8_MMA(1, 1, At, B1); PG8_BAR; PG8_SCHED;
            } else {
            PG8_LDB(B0, 0, 0); PG8_SCHED; PG8_LDA(At, 0, 0); PG8_STAGE(PG8_SA(1, 1), a1 + hstepA, voffA);
            PG8_WAIT_L(8); PG8_BAR; PG8_WAIT_L(0); PG8_MMA(0, 0, At, B0); PG8_BAR; PG8_SCHED;
            PG8_LDB(B1, 0, 1); PG8_STAGE(PG8_SB(0, 0), b2, voffB);
            PG8_BAR; PG8_WAIT_L(0); PG8_MMA(0, 1, At, B1); PG8_BAR;
            PG8_LDA(At, 0, 1); PG8_STAGE(PG8_SA(0, 0), a2, voffA);
            PG8_BAR; PG8_WAIT_L(0); PG8_MMA(1, 0, At, B0); PG8_BAR; PG8_SCHED;
            PG8_STAGE(PG8_SB(0, 1), b2 + hstep, voffB);
            PG8_WAIT_V(6); PG8_BAR; PG8_MMA(1, 1, At, B1); PG8_BAR;
            PG8_LDB(B0, 1, 0); PG8_SCHED; PG8_LDA(At, 1, 0); PG8_STAGE(PG8_SA(0, 1), a2 + hstepA, voffA);
            PG8_WAIT_L(8); PG8_BAR; PG8_WAIT_L(0); PG8_MMA(0, 0, At, B0); PG8_BAR; PG8_SCHED;
            PG8_LDB(B1, 1, 1); PG8_STAGE(PG8_SB(1, 0), b3, voffB);
            PG8_BAR; PG8_WAIT_L(0); PG8_MMA(0, 1, At, B1); PG8_BAR;
            PG8_LDA(At, 1, 1); PG8_STAGE(PG8_SA(1, 0), a3, voffA);
            PG8_BAR; PG8_WAIT_L(0); PG8_MMA(1, 0, At, B0); PG8_BAR; PG8_SCHED;
            PG8_STAGE(PG8_SB(1, 1), b3 + hstep, voffB);
            PG8_WAIT_V(6); PG8_BAR; PG8_MMA(1, 1, At, B1); PG8_BAR;
            }
        }
        if constexpr (ALIGN_EPI) { if (wr == 0) PG8_BAR; }
        if constexpr (!Epi::AFTER_DRAIN) { E(acc, cur, wr, wc, fr, fq); S.done(cur); }
        if (!has_next) break;
#pragma unroll
        for (int a = 0; a < 2; ++a)
#pragma unroll
            for (int b = 0; b < 2; ++b)
#pragma unroll
                for (int m = 0; m < 4; ++m)
#pragma unroll
                    for (int n = 0; n < 2; ++n) acc[a][b][m][n] = (f32x4){0.f, 0.f, 0.f, 0.f};
        cur = nxt; cA = nA; cB = nB; ++ui;
        if constexpr (ALIGN_EPI) { if (wr == 1) PG8_BAR; }
    }
    PG8_WAIT_V(0);
    if constexpr (!ALIGN_EPI) { if (wr == 0) PG8_BAR; }
    PG8_BAR;
    if constexpr (Epi::AFTER_DRAIN) { E.fused(acc, cur, wr, wc, fr, fq, lds, wid, lane); S.done(cur); }
#undef PG8_SA
#undef PG8_SB
#undef PG8_STAGE
#undef PG8_LDA
#undef PG8_LDB
#undef PG8_MMA
#undef PG8_WAIT_V
#undef PG8_WAIT_L
#undef PG8_BAR
#undef PG8_SCHED
}
}
#include <hip/hip_bf16.h>
#include <cmath>
namespace attn_body {
using bf16=__hip_bfloat16;
using bf16x8=__attribute__((ext_vector_type(8)))short;
using s16x4=__attribute__((ext_vector_type(4)))short;
using f32x16=__attribute__((ext_vector_type(16)))float;
using u32x4=__attribute__((ext_vector_type(4)))unsigned;
constexpr int D=64,QP=1024,KP=128;
constexpr int NW=8,QBLK=32,QB=QBLK*NW,KVBLK=64;
__device__ __forceinline__ int crow(int r,int hi){return (r&3)+8*(r>>2)+4*hi;}
#define SBAR() __builtin_amdgcn_sched_barrier(0)
__device__ __forceinline__ void cmask(f32x16&p0,f32x16&p1,int jb,int qrel,int hi){
  const float NEG=-INFINITY; int kb=64*jb+4*hi;
  #pragma unroll
  for(int r=0;r<16;++r){int kv=kb+(r&3)+8*(r>>2); if(kv>qrel)p0[r]=NEG; if(kv+32>qrel)p1[r]=NEG;}
}

constexpr int NSLOT=3, SLOTB=8192;
constexpr int LDS_K=0, LDS_V=NSLOT*SLOTB, LDS_WS=2*NSLOT*SLOTB, LDS_OST=LDS_WS+NW*64*4, LDS_BYTES=LDS_OST+NW*4096;
constexpr float C2=0.125f*1.4426950408889634f;
__device__ __forceinline__ void glds16(const void*gsrc,unsigned lds_dst){unsigned keep;
  asm volatile("s_mov_b32 %0, m0\n\ts_mov_b32 m0, %2\n\ts_nop 0\n\tglobal_load_lds_dwordx4 %1, off\n\ts_mov_b32 m0, %0":"=&s"(keep):"v"(gsrc),"s"(lds_dst):"memory");}
__device__ __forceinline__ float max3f(float a,float b,float c){float r;asm("v_max3_f32 %0, %1, %2, %3":"=v"(r):"v"(a),"v"(b),"v"(c));return r;}
__device__ __forceinline__ float max2f(float a,float b){float r;asm("v_max_f32_e32 %0, %1, %2":"=v"(r):"v"(a),"v"(b));return r;}
__device__ __forceinline__ float fadd_s(float a,float b){float r;asm("v_add_f32_e32 %0, %1, %2":"=v"(r):"v"(a),"v"(b));return r;}
__device__ __forceinline__ float fsub_s(float a,float b){float r;asm("v_sub_f32_e32 %0, %1, %2":"=v"(r):"v"(a),"v"(b));return r;}
typedef float f32x2_t __attribute__((ext_vector_type(2))); typedef __bf16 bf16x2_t __attribute__((ext_vector_type(2)));
__device__ __forceinline__ unsigned cvtpk_s(float lo,float hi){f32x2_t v={lo,hi};bf16x2_t b=__builtin_convertvector(v,bf16x2_t);return __builtin_bit_cast(unsigned,b);}
#define WAIT_BAR(N) asm volatile("s_waitcnt vmcnt(" #N ") lgkmcnt(0)\n\ts_barrier":::"memory")

__device__ __forceinline__ void qkt(f32x16&p0,f32x16&p1,const char*Kslot,const bf16x8*qr,const f32x16&negm,int r32,int hi){
  const char*kb=Kslot+hi*1024+r32*16;
  #pragma unroll
  for(int d0=0;d0<4;++d0){
    const bf16x8 b0=*reinterpret_cast<const bf16x8*>(kb+d0*2048);
    const bf16x8 b1=*reinterpret_cast<const bf16x8*>(kb+d0*2048+512);
    if(d0==0){p0=__builtin_amdgcn_mfma_f32_32x32x16_bf16(b0,qr[0],negm,0,0,0);p1=__builtin_amdgcn_mfma_f32_32x32x16_bf16(b1,qr[0],negm,0,0,0);}
    else{p0=__builtin_amdgcn_mfma_f32_32x32x16_bf16(b0,qr[d0],p0,0,0,0);p1=__builtin_amdgcn_mfma_f32_32x32x16_bf16(b1,qr[d0],p1,0,0,0);}}
}
typedef __attribute__((address_space(3))) const char* lds_cptr;
typedef short v4i16_t __attribute__((ext_vector_type(4)));
__device__ __forceinline__ void kload8(bf16x8*kf,lds_cptr kp){
  kf[0]=*(const __attribute__((address_space(3))) bf16x8*)(kp);      kf[1]=*(const __attribute__((address_space(3))) bf16x8*)(kp+512);
  kf[2]=*(const __attribute__((address_space(3))) bf16x8*)(kp+2048); kf[3]=*(const __attribute__((address_space(3))) bf16x8*)(kp+2560);
  kf[4]=*(const __attribute__((address_space(3))) bf16x8*)(kp+4096); kf[5]=*(const __attribute__((address_space(3))) bf16x8*)(kp+4608);
  kf[6]=*(const __attribute__((address_space(3))) bf16x8*)(kp+6144); kf[7]=*(const __attribute__((address_space(3))) bf16x8*)(kp+6656);
}
__device__ __forceinline__ void kload2(bf16x8*kf,lds_cptr kp,int j){ kf[2*j]=*(const __attribute__((address_space(3))) bf16x8*)(kp+j*2048); kf[2*j+1]=*(const __attribute__((address_space(3))) bf16x8*)(kp+j*2048+512); }
__device__ __forceinline__ s16x4 vtr(lds_cptr p){ return __builtin_bit_cast(s16x4,__builtin_amdgcn_ds_read_tr16_b64_v4i16((__attribute__((address_space(3))) v4i16_t*)p)); }
__device__ __forceinline__ float rowmax(const f32x16&p0,const f32x16&p1){
  float a=max3f(p0[0],p0[1],p1[0]),b=max3f(p0[2],p0[3],p1[1]);a=max3f(a,p1[2],p1[3]);
  #pragma unroll
  for(int r=4;r<16;r+=4){a=max3f(a,p0[r],p0[r+1]);b=max3f(b,p0[r+2],p0[r+3]);a=max3f(a,p1[r],p1[r+1]);b=max3f(b,p1[r+2],p1[r+3]);}
  const float m=max2f(a,b);
  auto rr=__builtin_amdgcn_permlane32_swap(__float_as_uint(m),__float_as_uint(m),false,false);
  return max2f(__uint_as_float(rr[0]),__uint_as_float(rr[1]));
}
__device__ __forceinline__ void pv(f32x16*o,int vb,bf16x8 pa0,bf16x8 pa1,bf16x8 pa2,bf16x8 pa3){
  #pragma unroll
  for(int d0=0;d0<2;++d0){s16x4 lo[4],hi[4];
    #pragma unroll
    for(int ks=0;ks<4;++ks){
      asm volatile("ds_read_b64_tr_b16 %0,%1 offset:%c2":"=&v"(lo[ks]):"v"(vb),"i"(d0*4096+ks*1024):"memory");
      asm volatile("ds_read_b64_tr_b16 %0,%1 offset:%c2":"=&v"(hi[ks]):"v"(vb),"i"(d0*4096+ks*1024+512):"memory");}
    asm volatile("s_waitcnt lgkmcnt(0)":::"memory");SBAR();
    #define PK(k) (bf16x8){lo[k][0],lo[k][1],lo[k][2],lo[k][3],hi[k][0],hi[k][1],hi[k][2],hi[k][3]}
    o[d0]=__builtin_amdgcn_mfma_f32_32x32x16_bf16(pa0,PK(0),o[d0],0,0,0);
    o[d0]=__builtin_amdgcn_mfma_f32_32x32x16_bf16(pa1,PK(1),o[d0],0,0,0);
    o[d0]=__builtin_amdgcn_mfma_f32_32x32x16_bf16(pa2,PK(2),o[d0],0,0,0);
    o[d0]=__builtin_amdgcn_mfma_f32_32x32x16_bf16(pa3,PK(3),o[d0],0,0,0);
    #undef PK
  }
}

#ifndef ATTN_STORE16
#define ATTN_STORE16(p,v) (*(u32x4*)(p)=(v))
#endif
template<int THRL> __device__ __forceinline__ void attn_unit(long qrow0,int h,long kvrow0,int NT,const bf16*Q,const bf16*__restrict__ K,const bf16*__restrict__ V,bf16*O,char*shm){
  int tid_=threadIdx.x; asm volatile("":"+v"(tid_)); const int tid=tid_,lane=tid&63,r32=lane&31,hi=lane>>5; const int wid=__builtin_amdgcn_readfirstlane(tid>>6);
  const bf16*Qw=Q+(qrow0+wid*QBLK)*QP+h*D;
  const bf16*Kh=K+kvrow0*KP+(h>>2)*D,*Vh=V+kvrow0*KP+(h>>2)*D;
  const unsigned lds0=(unsigned)(uintptr_t)shm;
  float*wsf=(float*)(shm+LDS_WS)+wid*64;
  const bf16*ksrc=Kh+(long)lane*KP+wid*8;
  const bf16*vsrc=Vh+(long)(16*(wid&3)+(lane>>2))*KP+(wid>>2)*32+(lane&3)*8;
  const unsigned kdst=lds0+LDS_K+wid*1024, vdst=lds0+LDS_V+wid*1024;
  #define DMA_K(t,slot) glds16(ksrc+(long)(t)*KVBLK*KP,(unsigned)__builtin_amdgcn_readfirstlane(kdst+(slot)))
  #define DMA_V(t,slot) glds16(vsrc+(long)(t)*KVBLK*KP,(unsigned)__builtin_amdgcn_readfirstlane(vdst+(slot)))
  const int vb0=(int)(lds0+LDS_V)+((lane>>4)&1)*32+(lane&3)*8+(4*hi+((lane&15)>>2))*64;
  const char*Kbase=shm+LDS_K; bf16x8 kf[8];
  const lds_cptr shm3=(lds_cptr)shm; const lds_cptr kp0=shm3+LDS_K+hi*1024+r32*16; const lds_cptr vp0=shm3+LDS_V+((lane>>4)&1)*32+(lane&3)*8+(4*hi+((lane&15)>>2))*64;
  DMA_K(0,0);DMA_V(0,0);DMA_K(1,SLOTB);
  bf16x8 qr[4];
  #pragma unroll
  for(int d0=0;d0<4;++d0)qr[d0]=*reinterpret_cast<const bf16x8*>(&Qw[(long)r32*QP+d0*16+hi*8]);
  float mhat=0.f,l_reg=0.f;f32x16 o[2];o[0]=f32x16{};o[1]=f32x16{};f32x16 negm=f32x16{};asm volatile("":"+v"(negm));
  #define CMASK(P0,P1,t) do{}while(0)
  bool resc=false;
  #define START(P0,P1) do{ const float rm=rowmax(P0,P1); resc=false; \
    { const float dl=rm; mhat=fadd_s(mhat,dl); \
      _Pragma("unroll") for(int r=0;r<16;++r){P0[r]=fsub_s(P0[r],dl);P1[r]=fsub_s(P1[r],dl);} \
      _Pragma("unroll") for(int r=0;r<16;++r)negm[r]=-mhat; asm volatile("":"+v"(negm)); } \
    _Pragma("unroll") for(int r=0;r<16;++r)P0[r]=__builtin_amdgcn_exp2f(P0[r]); }while(0)
  #define RESC() do{ if(resc){ asm volatile("s_waitcnt lgkmcnt(0)":::"memory"); \
      _Pragma("unroll") for(int d_=0;d_<2;++d_) _Pragma("unroll") for(int r=0;r<16;++r)o[d_][r]*=wsf[crow(r,hi)]; } }while(0)
  f32x16 pA0,pA1,pB0,pB1;
  int sl_prev=0,sl_cur=0,sl_next=SLOTB;
  #define ROT() do{sl_prev=sl_cur;sl_cur=sl_next;sl_next=(sl_next==(NSLOT-1)*SLOTB)?0:sl_next+SLOTB;}while(0)
  DMA_K(2,2*SLOTB);
  WAIT_BAR(3);
  qkt(pA0,pA1,Kbase,qr,negm,r32,hi);asm volatile("s_nop 15\n\ts_nop 7":"+v"(pA0),"+v"(pA1));CMASK(pA0,pA1,0);
  START(pA0,pA1);
  _Pragma("unroll") for(int r=0;r<16;++r)pA1[r]=__builtin_amdgcn_exp2f(pA1[r]);
  WAIT_BAR(0);
  DMA_K(3,0);DMA_V(1,SLOTB);
  ROT();
  kload8(kf,kp0+sl_cur);
  WAIT_BAR(2);
  s16x4 vlo[8],vhi[8]; u32x4 pw0,pw1,pw2,pw3;
  #define PKW(P,B) cvtpk_s(P[B],P[B+1])
  #define PAF(k) __builtin_bit_cast(bf16x8,pw##k)
  #define VFR(i) (bf16x8){vlo[i][0],vlo[i][1],vlo[i][2],vlo[i][3],vhi[i][0],vhi[i][1],vhi[i][2],vhi[i][3]}
  #define PIN(x) asm volatile("":"+v"(x))
  #define MX3(a,b,c) __builtin_fmaxf(__builtin_fmaxf((a),(b)),(c))
  #define GAPA(MF,A0,A1,A2,A3,W0,W1,PW) do{ MF; sacc+=A0; sacc+=A1; sacc+=A2; sacc+=A3; PIN(sacc); W0; W1; PIN(PW); SBAR(); }while(0)
  #define EX(v) __builtin_amdgcn_exp2f(v)
  #define GAPB(MF,X,B) do{ MF; X[B]=EX(X[B]); X[B+1]=EX(X[B+1]); X[B+2]=EX(X[B+2]); X[B+3]=EX(X[B+3]); PIN(X); SBAR(); }while(0)
  #define VRD(i) do{ vlo[i]=vtr(vp_+(((i)>>2)*4096+((i)&3)*1024)); vhi[i]=vtr(vp_+(((i)>>2)*4096+((i)&3)*1024+512)); }while(0)
  #define KRD(G,j) do{ if(G){ kload2(kf,kp0+sl_next,j); SBAR(); } }while(0)
  #define STEP(C0,C1,P0,P1,t,GK,GV,GL) do{ SBAR(); \
    const lds_cptr vp_=vp0+sl_prev; \
    VRD(0); SBAR(); float sacc=(P0[0]+P0[1]); \
    GAPA(C0=__builtin_amdgcn_mfma_f32_32x32x16_bf16(kf[0],qr[0],negm,0,0,0), P0[2],P0[3],P0[4],P0[5],     pw0[0]=PKW(P0,0), pw0[1]=PKW(P0,2), pw0); \
    VRD(4); SBAR(); GAPA(C1=__builtin_amdgcn_mfma_f32_32x32x16_bf16(kf[1],qr[0],negm,0,0,0), P0[6],P0[7],P0[8],P0[9],     pw0[2]=PKW(P0,4), pw0[3]=PKW(P0,6), pw0); \
    VRD(1); SBAR(); GAPA(C0=__builtin_amdgcn_mfma_f32_32x32x16_bf16(kf[2],qr[1],C0,0,0,0),   P0[10],P0[11],P0[12],P0[13], pw1[0]=PKW(P0,8), pw1[1]=PKW(P0,10), pw1); \
    VRD(5); SBAR(); GAPA(C1=__builtin_amdgcn_mfma_f32_32x32x16_bf16(kf[3],qr[1],C1,0,0,0),   P0[14],P0[15],P1[0],P1[1],   pw1[2]=PKW(P0,12),pw1[3]=PKW(P0,14), pw1); \
    VRD(2); SBAR(); GAPA(C0=__builtin_amdgcn_mfma_f32_32x32x16_bf16(kf[4],qr[2],C0,0,0,0),   P1[2],P1[3],P1[4],P1[5],     pw2[0]=PKW(P1,0), pw2[1]=PKW(P1,2), pw2); \
    VRD(6); SBAR(); GAPA(C1=__builtin_amdgcn_mfma_f32_32x32x16_bf16(kf[5],qr[2],C1,0,0,0),   P1[6],P1[7],P1[8],P1[9],     pw2[2]=PKW(P1,4), pw2[3]=PKW(P1,6), pw2); \
    VRD(3); SBAR(); GAPA(C0=__builtin_amdgcn_mfma_f32_32x32x16_bf16(kf[6],qr[3],C0,0,0,0),   P1[10],P1[11],P1[12],P1[13], pw3[0]=PKW(P1,8), pw3[1]=PKW(P1,10), pw3); \
    VRD(7); SBAR(); GAPA(C1=__builtin_amdgcn_mfma_f32_32x32x16_bf16(kf[7],qr[3],C1,0,0,0),   P1[14],P1[15],0.f,0.f,       pw3[2]=PKW(P1,12),pw3[3]=PKW(P1,14), pw3); \
    l_reg+=sacc; \
    if(GK){DMA_K((t)+3,sl_cur);} if(GV){DMA_V((t)+1,sl_next);} \
    CMASK(C0,C1,t); \
    { float a=MX3(C0[0],C0[1],C1[0]),b=MX3(C0[2],C0[3],C1[1]); a=MX3(a,C1[2],C1[3]); \
      _Pragma("unroll") for(int r=4;r<16;r+=4){a=MX3(a,C0[r],C0[r+1]);b=MX3(b,C0[r+2],C0[r+3]);a=MX3(a,C1[r],C1[r+1]);b=MX3(b,C1[r+2],C1[r+3]);} \
      float rm=__builtin_fmaxf(a,b); { auto rr=__builtin_amdgcn_permlane32_swap(__float_as_uint(rm),__float_as_uint(rm),false,false); rm=__builtin_fmaxf(__uint_as_float(rr[0]),__uint_as_float(rr[1])); } \
      resc=false; \
      if(__builtin_expect(__any(rm>(float)THRL),0)){ const float dl=__builtin_fmaxf(rm,0.f); mhat+=dl; \
        _Pragma("unroll") for(int r=0;r<16;++r){C0[r]-=dl;C1[r]-=dl;} \
        _Pragma("unroll") for(int r=0;r<16;++r)negm[r]=-mhat; asm volatile("":"+v"(negm)); \
        const float f=__builtin_amdgcn_exp2f(-dl); l_reg*=f; if(hi==0)wsf[r32]=f; resc=true; } } \
    SBAR(); \
    GAPB(o[0]=__builtin_amdgcn_mfma_f32_32x32x16_bf16(PAF(0),VFR(0),o[0],0,0,0), C0,0); \
    GAPB(o[1]=__builtin_amdgcn_mfma_f32_32x32x16_bf16(PAF(0),VFR(4),o[1],0,0,0), C0,4); \
    KRD(GL,0); GAPB(o[0]=__builtin_amdgcn_mfma_f32_32x32x16_bf16(PAF(1),VFR(1),o[0],0,0,0), C0,8); \
    KRD(GL,1); GAPB(o[1]=__builtin_amdgcn_mfma_f32_32x32x16_bf16(PAF(1),VFR(5),o[1],0,0,0), C0,12); \
    KRD(GL,2); GAPB(o[0]=__builtin_amdgcn_mfma_f32_32x32x16_bf16(PAF(2),VFR(2),o[0],0,0,0), C1,0); \
    KRD(GL,3); GAPB(o[1]=__builtin_amdgcn_mfma_f32_32x32x16_bf16(PAF(2),VFR(6),o[1],0,0,0), C1,4); \
    GAPB(o[0]=__builtin_amdgcn_mfma_f32_32x32x16_bf16(PAF(3),VFR(3),o[0],0,0,0), C1,8); \
    GAPB(o[1]=__builtin_amdgcn_mfma_f32_32x32x16_bf16(PAF(3),VFR(7),o[1],0,0,0), C1,12); \
    }while(0)
  int t=1;
  #undef CMASK
  #define CMASK(P0,P1,t) do{}while(0)
  for(;t+5<NT;t+=2){
    STEP(pB0,pB1,pA0,pA1,t,true,true,true);     WAIT_BAR(2); RESC(); ROT();
    STEP(pA0,pA1,pB0,pB1,t+1,true,true,true);   WAIT_BAR(2); RESC(); ROT();
  }
  #undef CMASK
  #define CMASK(P0,P1,t) do{}while(0)
  #define ENDW(tt) do{ if((tt)+3<NT){WAIT_BAR(2);} else if((tt)+2<NT){WAIT_BAR(1);} else {WAIT_BAR(0);} }while(0)
  for(;t+1<NT;t+=2){
    STEP(pB0,pB1,pA0,pA1,t,(t+3<NT),(t+1<NT),(t+1<NT));       ENDW(t);   RESC(); ROT();
    STEP(pA0,pA1,pB0,pB1,t+1,(t+4<NT),(t+2<NT),(t+2<NT));     ENDW(t+1); RESC(); ROT();
  }
  STEP(pB0,pB1,pA0,pA1,NT-1,false,false,false); RESC();
  { float sacc=pB0[0]+pB0[1]; _Pragma("unroll") for(int r=2;r<16;++r)sacc+=pB0[r]; _Pragma("unroll") for(int r=0;r<16;++r)sacc+=pB1[r]; l_reg+=sacc;
    pw0=(u32x4){PKW(pB0,0),PKW(pB0,2),PKW(pB0,4),PKW(pB0,6)};pw1=(u32x4){PKW(pB0,8),PKW(pB0,10),PKW(pB0,12),PKW(pB0,14)};pw2=(u32x4){PKW(pB1,0),PKW(pB1,2),PKW(pB1,4),PKW(pB1,6)};pw3=(u32x4){PKW(pB1,8),PKW(pB1,10),PKW(pB1,12),PKW(pB1,14)};
    SBAR(); pv(o,vb0+sl_cur,PAF(0),PAF(1),PAF(2),PAF(3)); }
  #undef PKW
  #undef PAF
  #undef VFR
  #undef PIN
  #undef MX3
  #undef GAPA
  #undef GAPB
  #undef EX
  #undef VRD
  #undef KRD
  #undef STEP
  #undef ENDW
  {auto rr=__builtin_amdgcn_permlane32_swap(__float_as_uint(l_reg),__float_as_uint(l_reg),false,false);l_reg=__uint_as_float(rr[0])+__uint_as_float(rr[1]);}
  if(hi==0)wsf[32+r32]=l_reg;asm volatile("s_waitcnt lgkmcnt(0)":::"memory");
  float rli[16];
  #pragma unroll
  for(int r=0;r<16;++r)rli[r]=__builtin_amdgcn_rcpf(wsf[32+crow(r,hi)]);
  bf16*Ow=O+(qrow0+wid*QBLK)*QP+h*D;
  { bf16*stg=(bf16*)(shm+LDS_OST)+wid*2048;
    #pragma unroll
    for(int r=0;r<16;++r){const int orow=crow(r,hi);
      #pragma unroll
      for(int d0=0;d0<2;++d0)stg[orow*64+d0*32+r32]=__float2bfloat16(o[d0][r]*rli[r]);}
    asm volatile("s_waitcnt lgkmcnt(0)":::"memory");
    #pragma unroll
    for(int i=0;i<4;++i){const int row=i*8+(lane>>3),ch=lane&7; const u32x4 v=*(const u32x4*)(stg+row*64+ch*8); ATTN_STORE16(Ow+(long)row*QP+ch*8,v);} }
  asm volatile("s_waitcnt lgkmcnt(0)\n\ts_barrier":::"memory");
  #undef DMA_K
  #undef DMA_V
  #undef CMASK
  #undef START
  #undef RESC
  #undef ROT
}
constexpr int ATTN_LDS_BYTES=LDS_BYTES;
#undef SBAR
#undef WAIT_BAR
}
__device__ const float ROPE_TAB[2048] = {
  1.000000000e+00f, 0.000000000e+00f, 1.000000000e+00f, 0.000000000e+00f, 1.000000000e+00f, 0.000000000e+00f, 1.000000000e+00f, 0.000000000e+00f,
  1.000000000e+00f, 0.000000000e+00f, 1.000000000e+00f, 0.000000000e+00f, 1.000000000e+00f, 0.000000000e+00f, 1.000000000e+00f, 0.000000000e+00f,
  1.000000000e+00f, 0.000000000e+00f, 1.000000000e+00f, 0.000000000e+00f, 1.000000000e+00f, 0.000000000e+00f, 1.000000000e+00f, 0.000000000e+00f,
  1.000000000e+00f, 0.000000000e+00f, 1.000000000e+00f, 0.000000000e+00f, 1.000000000e+00f, 0.000000000e+00f, 1.000000000e+00f, 0.000000000e+00f,
  5.403022766e-01f, 8.414709568e-01f, 8.460091352e-01f, 5.331684351e-01f, 9.504152536e-01f, 3.109835982e-01f, 9.842302203e-01f, 1.768921912e-01f,
  9.950041771e-01f, 9.983341396e-02f, 9.984192848e-01f, 5.620449781e-02f, 9.995000362e-01f, 3.161750734e-02f, 9.998418689e-01f, 1.778185740e-02f,
  9.999499917e-01f, 9.999833070e-03f, 9.999842048e-01f, 5.623383448e-03f, 9.999949932e-01f, 3.162272274e-03f, 9.999983907e-01f, 1.778278500e-03f,
  9.999995232e-01f, 9.999998147e-04f, 9.999998212e-01f, 5.623413017e-04f, 9.999999404e-01f, 3.162277571e-04f, 1.000000000e+00f, 1.778279402e-04f,
  -4.161468446e-01f, 9.092974067e-01f, 4.314628243e-01f, 9.021307230e-01f, 8.065783978e-01f, 5.911270976e-01f, 9.374182820e-01f, 3.482052684e-01f,
  9.800665975e-01f, 1.986693293e-01f, 9.936820865e-01f, 1.122313142e-01f, 9.980006814e-01f, 6.320339441e-02f, 9.993675947e-01f, 3.555808961e-02f,
  9.998000264e-01f, 1.999866590e-02f, 9.999367595e-01f, 1.124658901e-02f, 9.999799728e-01f, 6.324513350e-03f, 9.999936819e-01f, 3.556551412e-03f,
  9.999979734e-01f, 1.999998698e-03f, 9.999993443e-01f, 1.124682371e-03f, 9.999998212e-01f, 6.324555143e-04f, 9.999999404e-01f, 3.556558804e-04f,
  -9.899924994e-01f, 1.411200017e-01f, -1.159661412e-01f, 9.932531714e-01f, 5.827535987e-01f, 8.126488924e-01f, 8.610406518e-01f, 5.085361600e-01f,
  9.553365111e-01f, 2.955202162e-01f, 9.858034849e-01f, 1.679033041e-01f, 9.955033660e-01f, 9.472609311e-02f, 9.985772967e-01f, 5.332307890e-02f,
  9.995500445e-01f, 2.999550104e-02f, 9.998577237e-01f, 1.686943881e-02f, 9.999549985e-01f, 9.486691095e-03f, 9.999857545e-01f, 5.334813148e-03f,
  9.999955297e-01f, 2.999995602e-03f, 9.999985695e-01f, 1.687023207e-03f, 9.999995232e-01f, 9.486831841e-04f, 9.999998808e-01f, 5.334838061e-04f,
  -6.536436081e-01f, -7.568024993e-01f, -6.276796460e-01f, 7.784717679e-01f, 3.011374772e-01f, 9.535807371e-01f, 7.575061917e-01f, 6.528279781e-01f,
  9.210609794e-01f, 3.894183338e-01f, 9.748082757e-01f, 2.230444849e-01f, 9.920106530e-01f, 1.261540651e-01f, 9.974712729e-01f, 7.107120752e-02f,
  9.992001057e-01f, 3.998933360e-02f, 9.997470379e-01f, 2.249175683e-02f, 9.999200106e-01f, 1.264877338e-02f, 9.999747276e-01f, 7.113057654e-03f,
  9.999920130e-01f, 3.999989480e-03f, 9.999974966e-01f, 2.249363344e-03f, 9.999992251e-01f, 1.264910679e-03f, 9.999997616e-01f, 7.113117026e-04f,
  2.836622000e-01f, -9.589242935e-01f, -9.460792542e-01f, 3.239352107e-01f, -1.034231856e-02f, 9.999465346e-01f, 6.300802827e-01f, 7.765299678e-01f,
  8.775825500e-01f, 4.794255495e-01f, 9.607312679e-01f, 2.774805427e-01f, 9.875259995e-01f, 1.574558914e-01f, 9.960497618e-01f, 8.879686147e-02f,
  9.987502694e-01f, 4.997916892e-02f, 9.996047616e-01f, 2.811336145e-02f, 9.998750091e-01f, 1.581072994e-02f, 9.999604821e-01f, 8.891279809e-03f,
  9.999874830e-01f, 4.999979399e-03f, 9.999960661e-01f, 2.811702900e-03f, 9.999987483e-01f, 1.581138116e-03f, 9.999995828e-01f, 8.891395992e-04f,
  9.601702690e-01f, -2.794154882e-01f, -9.731037021e-01f, -2.303674817e-01f, -3.207964599e-01f, 9.471481442e-01f, 4.827820063e-01f, 8.757405877e-01f,
  8.253356218e-01f, 5.646424890e-01f, 9.436169863e-01f, 3.310393393e-01f, 9.820539355e-01f, 1.886002868e-01f, 9.943132997e-01f, 1.064944342e-01f,
  9.982005358e-01f, 5.996400490e-02f, 9.994308352e-01f, 3.373407945e-02f, 9.998199940e-01f, 1.897252724e-02f, 9.999430776e-01f, 1.066947356e-02f,
  9.999819994e-01f, 5.999964196e-03f, 9.999943376e-01f, 3.374041524e-03f, 9.999982119e-01f, 1.897365437e-03f, 9.999994040e-01f, 1.066967496e-03f,
  7.539022565e-01f, 6.569865942e-01f, -7.004299164e-01f, -7.137211561e-01f, -5.994374156e-01f, 8.004216552e-01f, 3.202569783e-01f, 9.473307133e-01f,
  7.648422122e-01f, 6.442176700e-01f, 9.235194325e-01f, 3.835515678e-01f, 9.755998850e-01f, 2.195560932e-01f, 9.922624230e-01f, 1.241583377e-01f,
  9.975510240e-01f, 6.994284689e-02f, 9.992253184e-01f, 3.935372829e-02f, 9.997550249e-01f, 2.213413641e-02f, 9.999225140e-01f, 1.244763471e-02f,
  9.999755025e-01f, 6.999942940e-03f, 9.999922514e-01f, 3.936379217e-03f, 9.999975562e-01f, 2.213592641e-03f, 9.999992251e-01f, 1.244795276e-03f,
  -1.455000341e-01f, 9.893582463e-01f, -2.120365053e-01f, -9.772617221e-01f, -8.186324835e-01f, 5.743177533e-01f, 1.476311982e-01f, 9.890424609e-01f,
  6.967067122e-01f, 7.173560858e-01f, 9.005023241e-01f, 4.348512292e-01f, 9.681702852e-01f, 2.502923608e-01f, 9.898977876e-01f, 1.417829692e-01f,
  9.968017340e-01f, 7.991469651e-02f, 9.989882708e-01f, 4.497213289e-02f, 9.996800423e-01f, 2.529552206e-02f, 9.998987913e-01f, 1.422575582e-02f,
  9.999679923e-01f, 7.999914698e-03f, 9.999898672e-01f, 4.498715512e-03f, 9.999967813e-01f, 2.529819496e-03f, 9.999989867e-01f, 1.422623056e-03f,
  -9.111302495e-01f, 4.121184945e-01f, 3.416603208e-01f, -9.398235083e-01f, -9.566441774e-01f, 2.912591100e-01f, -2.965079620e-02f, 9.995602965e-01f,
  6.216099858e-01f, 7.833269238e-01f, 8.746382594e-01f, 4.847761393e-01f, 9.597726464e-01f, 2.807783484e-01f, 9.872201085e-01f, 1.593627781e-01f,
  9.959527254e-01f, 8.987855166e-02f, 9.987195730e-01f, 5.058911443e-02f, 9.995950460e-01f, 2.845665626e-02f, 9.998719096e-01f, 1.600383222e-02f,
  9.999595284e-01f, 8.999878541e-03f, 9.999871850e-01f, 5.061050411e-03f, 9.999959469e-01f, 2.846046118e-03f, 9.999987483e-01f, 1.600450836e-03f,
  -8.390715122e-01f, -5.440211296e-01f, 7.901319861e-01f, -6.129367352e-01f, -9.997860789e-01f, -2.068353072e-02f, -2.059976161e-01f, 9.785525203e-01f,
  5.403022766e-01f, 8.414709568e-01f, 8.460091352e-01f, 5.331684351e-01f, 9.504152536e-01f, 3.109835982e-01f, 9.842302203e-01f, 1.768921912e-01f,
  9.950041771e-01f, 9.983341396e-02f, 9.984192848e-01f, 5.620449781e-02f, 9.995000362e-01f, 3.161750734e-02f, 9.998418689e-01f, 1.778185740e-02f,
  9.999499917e-01f, 9.999833070e-03f, 9.999842048e-01f, 5.623383448e-03f, 9.999949932e-01f, 3.162272274e-03f, 9.999983907e-01f, 1.778278500e-03f,
  4.425697960e-03f, -9.999902248e-01f, 9.952573776e-01f, -9.727665782e-02f, -9.437797070e-01f, -3.305750191e-01f, -3.758473694e-01f, 9.266815782e-01f,
  4.535961151e-01f, 8.912073374e-01f, 8.147053123e-01f, 5.798751712e-01f, 9.401075840e-01f, 3.408778608e-01f, 9.809291363e-01f, 1.943656653e-01f,
  9.939560890e-01f, 1.097782999e-01f, 9.980874062e-01f, 6.181810424e-02f, 9.993950725e-01f, 3.477803990e-02f, 9.998086691e-01f, 1.955982670e-02f,
  9.999395013e-01f, 1.099977829e-02f, 9.999808669e-01f, 6.185715087e-03f, 9.999939203e-01f, 3.478498431e-03f, 9.999980927e-01f, 1.956106164e-03f,
  8.438539505e-01f, -5.365729332e-01f, 8.938616514e-01f, 4.483428895e-01f, -7.941792607e-01f, -6.076835394e-01f, -5.338431001e-01f, 8.455835581e-01f,
  3.623577654e-01f, 9.320390821e-01f, 7.808259130e-01f, 6.247486472e-01f, 9.288598895e-01f, 3.704313040e-01f, 9.773178697e-01f, 2.117776722e-01f,
  9.928086400e-01f, 1.197122037e-01f, 9.977239966e-01f, 6.742975861e-02f, 9.992800951e-01f, 3.793822601e-02f, 9.997723103e-01f, 2.133773267e-02f,
  9.999279976e-01f, 1.199971233e-02f, 9.999772310e-01f, 6.748044863e-03f, 9.999927878e-01f, 3.794724122e-03f, 9.999977350e-01f, 2.133933594e-03f,
  9.074468017e-01f, 4.201670289e-01f, 5.171728134e-01f, 8.558809757e-01f, -5.658205152e-01f, -8.245284557e-01f, -6.750016212e-01f, 7.378162146e-01f,
  2.674988210e-01f, 9.635581970e-01f, 7.444779873e-01f, 6.676470041e-01f, 9.166833758e-01f, 3.996143341e-01f, 9.733975530e-01f, 2.291227132e-01f,
  9.915618896e-01f, 1.296341419e-01f, 9.973290563e-01f, 7.303927839e-02f, 9.991551042e-01f, 4.109803215e-02f, 9.997327924e-01f, 2.311557345e-02f,
  9.999154806e-01f, 1.299963426e-02f, 9.999732971e-01f, 7.310372312e-03f, 9.999915361e-01f, 4.110949580e-03f, 9.999973178e-01f, 2.311761258e-03f,
  1.367372125e-01f, 9.906073809e-01f, -1.879581250e-02f, 9.998233318e-01f, -2.813496292e-01f, -9.596053362e-01f, -7.948709130e-01f, 6.067785621e-01f,
  1.699671447e-01f, 9.854497313e-01f, 7.057763934e-01f, 7.084347010e-01f, 9.035902619e-01f, 4.283978045e-01f, 9.691694379e-01f, 2.463953048e-01f,
  9.902160168e-01f, 1.395431161e-01f, 9.969025850e-01f, 7.864648104e-02f, 9.990201592e-01f, 4.425742477e-02f, 9.996901155e-01f, 2.489333972e-02f,
  9.999020100e-01f, 1.399954222e-02f, 9.999690056e-01f, 7.872696966e-03f, 9.999902248e-01f, 4.427174106e-03f, 9.999969006e-01f, 2.489588689e-03f,
  -7.596879005e-01f, 6.502878666e-01f, -5.489757061e-01f, 8.358383179e-01f, 3.102253191e-02f, -9.995186925e-01f, -8.896703720e-01f, 4.566033185e-01f,
  7.073719800e-02f, 9.974949956e-01f, 6.648435593e-01f, 7.469826341e-01f, 8.895936012e-01f, 4.567528665e-01f, 9.646348357e-01f, 2.635899782e-01f,
  9.887710810e-01f, 1.494381279e-01f, 9.964445233e-01f, 8.425120264e-02f, 9.988752007e-01f, 4.741637781e-02f, 9.996442795e-01f, 2.667102776e-02f,
  9.998875260e-01f, 1.499943715e-02f, 9.999644160e-01f, 8.435020223e-03f, 9.999887347e-01f, 4.743398633e-03f, 9.999964237e-01f, 2.667415887e-03f,
  -9.576594830e-01f, -2.879033089e-01f, -9.100810289e-01f, 4.144303203e-01f, 3.403182030e-01f, -9.403103590e-01f, -9.564100504e-01f, 2.920270562e-01f,
  -2.919952199e-02f, 9.995735884e-01f, 6.218088269e-01f, 7.831690907e-01f, 8.747074604e-01f, 4.846512675e-01f, 9.597951770e-01f, 2.807013094e-01f,
  9.872272611e-01f, 1.593182087e-01f, 9.959549904e-01f, 8.985326439e-02f, 9.987202883e-01f, 5.057485774e-02f, 9.995952845e-01f, 2.844863199e-02f,
  9.998720288e-01f, 1.599931717e-02f, 9.999595284e-01f, 8.997339755e-03f, 9.999871850e-01f, 5.059622694e-03f, 9.999959469e-01f, 2.845243318e-03f,
  -2.751633525e-01f, -9.613974690e-01f, -9.908980131e-01f, -1.346146613e-01f, 6.158646941e-01f, -7.878519297e-01f, -9.929850101e-01f, 1.182403937e-01f,
  -1.288444996e-01f, 9.916648269e-01f, 5.768082738e-01f, 8.168795705e-01f, 8.589466810e-01f, 5.120649934e-01f, 9.546520114e-01f, 2.977238595e-01f,
  9.855847955e-01f, 1.691823453e-01f, 9.954339862e-01f, 9.545248002e-02f, 9.985553622e-01f, 5.373283103e-02f, 9.995430708e-01f, 3.022614494e-02f,
  9.998555183e-01f, 1.699918136e-02f, 9.999542832e-01f, 9.559656493e-03f, 9.999855757e-01f, 5.375846289e-03f, 9.999954104e-01f, 3.023070283e-03f,
  6.603167057e-01f, -7.509872317e-01f, -7.665364742e-01f, -6.422007680e-01f, 8.303362727e-01f, -5.572627187e-01f, -9.982416630e-01f, -5.927551910e-02f,
  -2.272020876e-01f, 9.738476276e-01f, 5.299842358e-01f, 8.480075002e-01f, 8.423270583e-01f, 5.389667749e-01f, 9.492070079e-01f, 3.146522641e-01f,
  9.838436842e-01f, 1.790295690e-01f, 9.948815107e-01f, 1.010486782e-01f, 9.983804226e-01f, 5.689026415e-02f, 9.994877577e-01f, 3.200356290e-02f,
  9.998379946e-01f, 1.799902879e-02f, 9.999487996e-01f, 1.012197137e-02f, 9.999837875e-01f, 5.692068953e-03f, 9.999948740e-01f, 3.200897481e-03f,
  9.887046218e-01f, 1.498772055e-01f, -3.060956597e-01f, -9.520007372e-01f, 9.624637961e-01f, -2.714100182e-01f, -9.720142484e-01f, -2.349219024e-01f,
  -3.232895732e-01f, 9.463000894e-01f, 4.814846218e-01f, 8.764545321e-01f, 8.248651028e-01f, 5.653295517e-01f, 9.434618354e-01f, 3.314811885e-01f,
  9.820042253e-01f, 1.888588965e-01f, 9.942975044e-01f, 1.066416800e-01f, 9.981955290e-01f, 6.004713103e-02f, 9.994292855e-01f, 3.378088027e-02f,
  9.998195171e-01f, 1.899885759e-02f, 9.999428988e-01f, 1.068428159e-02f, 9.999819398e-01f, 6.008291617e-03f, 9.999942780e-01f, 3.378724447e-03f,
  4.080820680e-01f, 9.129452705e-01f, 2.486170530e-01f, -9.686018825e-01f, 9.991443753e-01f, 4.135821387e-02f, -9.151299596e-01f, -4.031589627e-01f,
  -4.161468446e-01f, 9.092974067e-01f, 4.314628243e-01f, 9.021307230e-01f, 8.065783978e-01f, 5.911270976e-01f, 9.374182820e-01f, 3.482052684e-01f,
  9.800665975e-01f, 1.986693293e-01f, 9.936820865e-01f, 1.122313142e-01f, 9.980006814e-01f, 6.320339441e-02f, 9.993675947e-01f, 3.555808961e-02f,
  9.998000264e-01f, 1.999866590e-02f, 9.999367595e-01f, 1.124658901e-02f, 9.999799728e-01f, 6.324513350e-03f, 9.999936819e-01f, 3.556551412e-03f,
  -5.477292538e-01f, 8.366556168e-01f, 7.267602086e-01f, -6.868912578e-01f, 9.367403388e-01f, 3.500249982e-01f, -8.293828964e-01f, -5.586805940e-01f,
  -5.048460960e-01f, 8.632093668e-01f, 3.800770044e-01f, 9.249548316e-01f, 7.874851823e-01f, 6.163336039e-01f, 9.310783744e-01f, 3.648192585e-01f,
  9.780309200e-01f, 2.084598988e-01f, 9.930352569e-01f, 1.178173944e-01f, 9.977958202e-01f, 6.635902822e-02f, 9.993028045e-01f, 3.733518720e-02f,
  9.997795224e-01f, 2.099845745e-02f, 9.999302626e-01f, 1.180889364e-02f, 9.999779463e-01f, 6.640734151e-03f, 9.999930263e-01f, 3.734378144e-03f,
  -9.999608397e-01f, -8.851309307e-03f, 9.810745120e-01f, -1.936306208e-01f, 7.814403176e-01f, 6.239799857e-01f, -7.174775004e-01f, -6.965816617e-01f,
  -5.885010958e-01f, 8.084964156e-01f, 3.274895847e-01f, 9.448547959e-01f, 7.676045299e-01f, 6.409237385e-01f, 9.244439602e-01f, 3.813178837e-01f,
  9.758974314e-01f, 2.182296216e-01f, 9.923570156e-01f, 1.233997494e-01f, 9.975810051e-01f, 6.951399893e-02f, 9.992348552e-01f, 3.911216930e-02f,
  9.997580051e-01f, 2.199822478e-02f, 9.999234676e-01f, 1.237119362e-02f, 9.999758005e-01f, 6.956954952e-03f, 9.999923706e-01f, 3.912204877e-03f,
  -5.328330398e-01f, -8.462204337e-01f, 9.332357049e-01f, 3.592647016e-01f, 5.486453176e-01f, 8.360552192e-01f, -5.829432011e-01f, -8.125129342e-01f,
  -6.662760377e-01f, 7.457051873e-01f, 2.738668323e-01f, 9.617676139e-01f, 7.469563484e-01f, 6.648730636e-01f, 9.175173044e-01f, 3.976959288e-01f,
  9.736663699e-01f, 2.279775292e-01f, 9.916474223e-01f, 1.289782077e-01f, 9.973561764e-01f, 7.266827673e-02f, 9.991636872e-01f, 4.088902473e-02f,
  9.997355342e-01f, 2.299797162e-02f, 9.999163747e-01f, 1.293348987e-02f, 9.999735355e-01f, 7.273174357e-03f, 9.999916553e-01f, 4.090031143e-03f,
  4.241790175e-01f, -9.055783749e-01f, 5.979772806e-01f, 8.015130162e-01f, 2.614414096e-01f, 9.652193189e-01f, -4.300231338e-01f, -9.028178453e-01f,
  -7.373937368e-01f, 6.754631996e-01f, 2.193782479e-01f, 9.756398797e-01f, 7.255613208e-01f, 6.881575584e-01f, 9.103004336e-01f, 4.139482081e-01f,
  9.713379741e-01f, 2.377026230e-01f, 9.909064770e-01f, 1.345525682e-01f, 9.971213937e-01f, 7.582182437e-02f, 9.990894198e-01f, 4.266574979e-02f,
  9.997119904e-01f, 2.399769612e-02f, 9.999089241e-01f, 1.349578239e-02f, 9.999712110e-01f, 7.589393295e-03f, 9.999908805e-01f, 4.267857410e-03f,
  9.912028313e-01f, -1.323517561e-01f, 7.855279744e-02f, 9.969099760e-01f, -5.168947205e-02f, 9.986631870e-01f, -2.635403275e-01f, -9.646483660e-01f,
  -8.011435866e-01f, 5.984721184e-01f, 1.641961187e-01f, 9.864277244e-01f, 7.034407258e-01f, 7.107539177e-01f, 9.027957320e-01f, 4.300695956e-01f,
  9.689124227e-01f, 2.474039644e-01f, 9.901341200e-01f, 1.401226968e-01f, 9.968766570e-01f, 7.897461951e-02f, 9.990119338e-01f, 4.444234073e-02f,
  9.996874928e-01f, 2.499739639e-02f, 9.999011755e-01f, 1.405807026e-02f, 9.999687672e-01f, 7.905611768e-03f, 9.999901056e-01f, 4.445683677e-03f,
  6.469193101e-01f, 7.625584602e-01f, -4.650645256e-01f, 8.852767944e-01f, -3.596943319e-01f, 9.330701828e-01f, -8.874560893e-02f, -9.960543513e-01f,
  -8.568887711e-01f, 5.155013800e-01f, 1.084948927e-01f, 9.940969944e-01f, 6.806167364e-01f, 7.326396108e-01f, 8.950055838e-01f, 4.460549653e-01f,
  9.663899541e-01f, 2.570805550e-01f, 9.893305302e-01f, 1.456883848e-01f, 9.966219068e-01f, 8.212661743e-02f, 9.989313483e-01f, 4.621879384e-02f,
  9.996620417e-01f, 2.599707060e-02f, 9.998931289e-01f, 1.462035347e-02f, 9.999662042e-01f, 8.221829310e-03f, 9.999893308e-01f, 4.623509943e-03f,
  -2.921388149e-01f, 9.563759565e-01f, -8.654505014e-01f, 5.009945035e-01f, -6.320285201e-01f, 7.749451399e-01f, 8.884811401e-02f, -9.960451722e-01f,
  -9.040721655e-01f, 4.273798764e-01f, 5.245066807e-02f, 9.986234903e-01f, 6.571122408e-01f, 7.537927628e-01f, 8.869323730e-01f, 4.618993104e-01f,
  9.637709260e-01f, 2.667314410e-01f, 9.884956479e-01f, 1.512494683e-01f, 9.963572025e-01f, 8.527779579e-02f, 9.988475442e-01f, 4.799509794e-02f,
  9.996355176e-01f, 2.699671872e-02f, 9.998847246e-01f, 1.518263202e-02f, 9.999635220e-01f, 8.538045920e-03f, 9.999884963e-01f, 4.801335745e-03f,
  -9.626058936e-01f, 2.709057927e-01f, -9.992934465e-01f, -3.758498281e-02f, -8.416847587e-01f, 5.399692059e-01f, 2.636395991e-01f, -9.646212459e-01f,
  -9.422223568e-01f, 3.349881470e-01f, -3.759374842e-03f, 9.999929070e-01f, 6.329506636e-01f, 7.741921544e-01f, 8.785787225e-01f, 4.775975943e-01f,
  9.610554576e-01f, 2.763556540e-01f, 9.876294732e-01f, 1.568057686e-01f, 9.960825443e-01f, 8.842812479e-02f, 9.987606406e-01f, 4.977125302e-02f,
  9.996080399e-01f, 2.799634077e-02f, 9.998760223e-01f, 1.574490592e-02f, 9.999607801e-01f, 8.854261599e-03f, 9.999876022e-01f, 4.979161546e-03f,
  -7.480575442e-01f, -6.636338830e-01f, -8.253722191e-01f, -5.645889640e-01f, -9.678716063e-01f, 2.514448166e-01f, 4.301160276e-01f, -9.027736187e-01f,
  -9.709581733e-01f, 2.392493337e-01f, -5.995753407e-02f, 9.982009530e-01f, 6.081562042e-01f, 7.938174009e-01f, 8.699472547e-01f, 4.931448400e-01f,
  9.582438469e-01f, 2.859522104e-01f, 9.867320657e-01f, 1.623571068e-01f, 9.957979321e-01f, 9.157756716e-02f, 9.986705780e-01f, 5.154724792e-02f,
  9.995795488e-01f, 2.899593487e-02f, 9.998670220e-01f, 1.630717516e-02f, 9.999579787e-01f, 9.170476347e-03f, 9.999867082e-01f, 5.156987347e-03f,
  1.542514563e-01f, -9.880316257e-01f, -3.972513974e-01f, -9.177098274e-01f, -9.980751872e-01f, -6.201520190e-02f, 5.830268264e-01f, -8.124529123e-01f,
  -9.899924994e-01f, 1.411200017e-01f, -1.159661412e-01f, 9.932531714e-01f, 5.827535987e-01f, 8.126488924e-01f, 8.610406518e-01f, 5.085361600e-01f,
  9.553365111e-01f, 2.955202162e-01f, 9.858034849e-01f, 1.679033041e-01f, 9.955033660e-01f, 9.472609311e-02f, 9.985772967e-01f, 5.332307890e-02f,
  9.995500445e-01f, 2.999550104e-02f, 9.998577237e-01f, 1.686943881e-02f, 9.999549985e-01f, 9.486691095e-03f, 9.999857545e-01f, 5.334813148e-03f,
  9.147423506e-01f, -4.040376544e-01f, 1.532156020e-01f, -9.881927967e-01f, -9.293001890e-01f, -3.693252206e-01f, 7.175492048e-01f, -6.965078115e-01f,
  -9.991351366e-01f, 4.158066213e-02f, -1.716081351e-01f, 9.851652980e-01f, 5.567682981e-01f, 8.306677938e-01f, 8.518617749e-01f, 5.237666368e-01f,
  9.523335695e-01f, 3.050586283e-01f, 9.848436713e-01f, 1.734442115e-01f, 9.951988459e-01f, 9.787367284e-02f, 9.984809160e-01f, 5.509874597e-02f,
  9.995195270e-01f, 3.099503554e-02f, 9.998480678e-01f, 1.743169874e-02f, 9.999519587e-01f, 9.802903980e-03f, 9.999848008e-01f, 5.512638018e-03f,
  8.342233896e-01f, 5.514267087e-01f, 6.564949751e-01f, -7.543303967e-01f, -7.683670521e-01f, -6.400094628e-01f, 8.294404149e-01f, -5.585952401e-01f,
  -9.982947707e-01f, -5.837414414e-02f, -2.267075777e-01f, 9.739628434e-01f, 5.302263498e-01f, 8.478561640e-01f, 8.424135447e-01f, 5.388315320e-01f,
  9.492354393e-01f, 3.145665526e-01f, 9.838528037e-01f, 1.789796203e-01f, 9.948843718e-01f, 1.010202691e-01f, 9.983813763e-01f, 5.687423423e-02f,
  9.994880557e-01f, 3.199454024e-02f, 9.998381138e-01f, 1.799395122e-02f, 9.999487996e-01f, 1.011911593e-02f, 9.999837875e-01f, 5.690463353e-03f,
  -1.327674743e-02f, 9.999118447e-01f, 9.575859308e-01f, -2.881479561e-01f, -5.312353373e-01f, -8.472242951e-01f, 9.151714444e-01f, -4.030647874e-01f,
  -9.874797463e-01f, -1.577456892e-01f, -2.810903192e-01f, 9.596813321e-01f, 5.031541586e-01f, 8.641967177e-01f, 8.326989412e-01f, 5.537259579e-01f,
  9.460423589e-01f, 3.240430355e-01f, 9.828307629e-01f, 1.845093668e-01f, 9.945599437e-01f, 1.041658595e-01f, 9.982786179e-01f, 5.864954367e-02f,
  9.994555712e-01f, 3.299400955e-02f, 9.998278022e-01f, 1.855619811e-02f, 9.999455214e-01f, 1.043532696e-02f, 9.999827743e-01f, 5.868288223e-03f,
  -8.485702872e-01f, 5.290827155e-01f, 9.637578130e-01f, 2.667787969e-01f, -2.414213270e-01f, -9.704204202e-01f, 9.720384479e-01f, -2.348218709e-01f,
  -9.667981863e-01f, -2.555411160e-01f, -3.345844150e-01f, 9.423657656e-01f, 4.755788445e-01f, 8.796731234e-01f, 8.227210045e-01f, 5.684453845e-01f,
  9.427546859e-01f, 3.334870934e-01f, 9.817776680e-01f, 1.900332868e-01f, 9.942255616e-01f, 1.073104069e-01f, 9.981727600e-01f, 6.042467058e-02f,
  9.994220734e-01f, 3.399344906e-02f, 9.998172522e-01f, 1.911843941e-02f, 9.999421835e-01f, 1.075153705e-02f, 9.999817014e-01f, 6.046113092e-03f,
  -9.036921859e-01f, -4.281826615e-01f, 6.731098294e-01f, 7.395425439e-01f, 7.233429700e-02f, -9.973804355e-01f, 9.982477427e-01f, -5.917278677e-02f,
  -9.364566803e-01f, -3.507832289e-01f, -3.870207071e-01f, 9.220710397e-01f, 4.475280046e-01f, 8.942699432e-01f, 8.124828935e-01f, 5.829849839e-01f,
  9.393727183e-01f, 3.428978026e-01f, 9.806935191e-01f, 1.955511868e-01f, 9.938812256e-01f, 1.104538888e-01f, 9.980637431e-01f, 6.219960377e-02f,
  9.993875623e-01f, 3.499285504e-02f, 9.998063445e-01f, 1.968067512e-02f, 9.999387264e-01f, 1.106774621e-02f, 9.999806285e-01f, 6.223937962e-03f,
  -1.279636919e-01f, -9.917788506e-01f, 1.751563251e-01f, 9.845406413e-01f, 3.789165616e-01f, -9.254308343e-01f, 9.929728508e-01f, 1.183425859e-01f,
  -8.967584372e-01f, -4.425204396e-01f, -4.382334948e-01f, 8.988611698e-01f, 4.190296531e-01f, 9.079725742e-01f, 8.019878864e-01f, 5.973402858e-01f,
  9.358968139e-01f, 3.522742391e-01f, 9.795783162e-01f, 2.010629177e-01f, 9.935269952e-01f, 1.135962531e-01f, 9.979515672e-01f, 6.397434324e-02f,
  9.993520975e-01f, 3.599222377e-02f, 9.997950792e-01f, 2.024290524e-02f, 9.999352098e-01f, 1.138395350e-02f, 9.999794960e-01f, 6.401762366e-03f,
  7.654140592e-01f, -6.435381174e-01f, -3.767421544e-01f, 9.263181686e-01f, 6.479219198e-01f, -7.617067695e-01f, 9.563800097e-01f, 2.921254933e-01f,
  -8.481000066e-01f, -5.298361182e-01f, -4.880608022e-01f, 8.728096485e-01f, 3.901123405e-01f, 9.207672477e-01f, 7.912392616e-01f, 6.115066409e-01f,
  9.323273301e-01f, 3.616154194e-01f, 9.784321785e-01f, 2.065682858e-01f, 9.931628108e-01f, 1.167374924e-01f, 9.978361726e-01f, 6.574887782e-02f,
  9.993155599e-01f, 3.699155897e-02f, 9.997835755e-01f, 2.080512792e-02f, 9.999315739e-01f, 1.170016080e-02f, 9.999783635e-01f, 6.579586305e-03f,
  9.550736547e-01f, 2.963685691e-01f, -8.126109242e-01f, 5.828065872e-01f, 8.526731730e-01f, -5.224446654e-01f, 8.896234035e-01f, 4.566948712e-01f,
  -7.909677029e-01f, -6.118578911e-01f, -5.363451242e-01f, 8.439987302e-01f, 3.608049452e-01f, 9.326413274e-01f, 7.802404761e-01f, 6.254796982e-01f,
  9.286646247e-01f, 3.709204793e-01f, 9.772551060e-01f, 2.120671123e-01f, 9.927886724e-01f, 1.198775619e-01f, 9.977176785e-01f, 6.752320379e-02f,
  9.992780685e-01f, 3.799085692e-02f, 9.997717142e-01f, 2.136734501e-02f, 9.999278188e-01f, 1.201636624e-02f, 9.999771714e-01f, 6.757410243e-03f,
  2.666429281e-01f, 9.637953639e-01f, -9.982103109e-01f, 5.980119109e-02f, 9.728653431e-01f, -2.313720286e-01f, 7.948085070e-01f, 6.068603396e-01f,
  -7.259323001e-01f, -6.877661347e-01f, -5.829338431e-01f, 8.125196099e-01f, 3.311367631e-01f, 9.435827732e-01f, 7.689948678e-01f, 6.392549276e-01f,
  9.249090552e-01f, 3.801884055e-01f, 9.760470986e-01f, 2.175592482e-01f, 9.924046397e-01f, 1.230164245e-01f, 9.975960255e-01f, 6.929731369e-02f,
  9.992396235e-01f, 3.899011388e-02f, 9.997594953e-01f, 2.192955278e-02f, 9.999239445e-01f, 1.233256981e-02f, 9.999759793e-01f, 6.935234182e-03f,
  -6.669380665e-01f, 7.451131344e-01f, -8.763791323e-01f, -4.816218913e-01f, 9.965789914e-01f, 8.264565468e-02f, 6.749256849e-01f, 7.378857136e-01f,
  -6.536436081e-01f, -7.568024993e-01f, -6.276796460e-01f, 7.784717679e-01f, 3.011374772e-01f, 9.535807371e-01f, 7.575061917e-01f, 6.528279781e-01f,
  9.210609794e-01f, 3.894183338e-01f, 9.748082757e-01f, 2.230444849e-01f, 9.920106530e-01f, 1.261540651e-01f, 9.974712729e-01f, 7.107120752e-02f,
  9.992001057e-01f, 3.998933360e-02f, 9.997470379e-01f, 2.249175683e-02f, 9.999200106e-01f, 1.264877338e-02f, 9.999747276e-01f, 7.113057654e-03f,
  -9.873392582e-01f, -1.586226672e-01f, -4.846391380e-01f, -8.747141957e-01f, 9.214624763e-01f, 3.884674013e-01f, 5.337560773e-01f, 8.456385136e-01f,
  -5.748239756e-01f, -8.182771206e-01f, -6.704410911e-01f, 7.419627905e-01f, 2.708370686e-01f, 9.626252055e-01f, 7.457779050e-01f, 6.661946774e-01f,
  9.171208143e-01f, 3.986093402e-01f, 9.735385776e-01f, 2.285226882e-01f, 9.916067719e-01f, 1.292904466e-01f, 9.973433018e-01f, 7.284487784e-02f,
  9.991596341e-01f, 4.098851234e-02f, 9.997342229e-01f, 2.305395156e-02f, 9.999159575e-01f, 1.296497509e-02f, 9.999734163e-01f, 7.290881127e-03f,
  -3.999853134e-01f, -9.165215492e-01f, 5.636087433e-02f, -9.984104633e-01f, 7.549650073e-01f, 6.557650566e-01f, 3.757520020e-01f, 9.267202616e-01f,
  -4.902608097e-01f, -8.715757728e-01f, -7.110829353e-01f, 7.031081319e-01f, 2.402658463e-01f, 9.707071185e-01f, 7.338138223e-01f, 6.793506145e-01f,
  9.130889177e-01f, 4.077604413e-01f, 9.722381234e-01f, 2.339936495e-01f, 9.911929369e-01f, 1.324255317e-01f, 9.972121716e-01f, 7.461831719e-02f,
  9.991181493e-01f, 4.198765382e-02f, 9.997211099e-01f, 2.361614071e-02f, 9.999117851e-01f, 1.328117587e-02f, 9.999721050e-01f, 7.468704134e-03f,
  5.551133156e-01f, -8.317747712e-01f, 5.800027847e-01f, -8.146145344e-01f, 5.135980844e-01f, 8.580308557e-01f, 2.058969140e-01f, 9.785736799e-01f,
  -4.007991850e-01f, -9.161659479e-01f, -7.494767904e-01f, 6.620306373e-01f, 2.094543874e-01f, 9.778184295e-01f, 7.216176987e-01f, 6.922917962e-01f,
  9.089657664e-01f, 4.168708026e-01f, 9.709069133e-01f, 2.394572198e-01f, 9.907692075e-01f, 1.355592906e-01f, 9.970778823e-01f, 7.639151812e-02f,
  9.990756512e-01f, 4.298675060e-02f, 9.997076392e-01f, 2.417832054e-02f, 9.999075532e-01f, 1.359737478e-02f, 9.999707937e-01f, 7.646527141e-03f,
  9.998432994e-01f, 1.770192571e-02f, 9.250143766e-01f, -3.799321353e-01f, 2.212979645e-01f, 9.752062559e-01f, 2.954792790e-02f, 9.995633364e-01f,
  -3.073328733e-01f, -9.516021013e-01f, -7.855011225e-01f, 6.188601851e-01f, 1.784334779e-01f, 9.839519858e-01f, 7.091933489e-01f, 7.050140500e-01f,
  9.047516584e-01f, 4.259394705e-01f, 9.695450068e-01f, 2.449132204e-01f, 9.903355837e-01f, 1.386916935e-01f, 9.969404936e-01f, 7.816448063e-02f,
  9.990321398e-01f, 4.398580268e-02f, 9.996939301e-01f, 2.474049293e-02f, 9.999032021e-01f, 1.391357277e-02f, 9.999693632e-01f, 7.824349217e-03f,
  5.253219604e-01f, 8.509035110e-01f, 9.851384163e-01f, 1.717624217e-01f, -9.294816852e-02f, 9.956709743e-01f, -1.477329880e-01f, 9.890272617e-01f,
  -2.107958049e-01f, -9.775301218e-01f, -8.190422058e-01f, 5.737332702e-01f, 1.472341716e-01f, 9.891016483e-01f, 6.965447664e-01f, 7.175133228e-01f,
  9.004471302e-01f, 4.349655211e-01f, 9.681524634e-01f, 2.503614724e-01f, 9.898920655e-01f, 1.418227106e-01f, 9.967998862e-01f, 7.993719727e-02f,
  9.989876747e-01f, 4.498481378e-02f, 9.996798635e-01f, 2.530265972e-02f, 9.998987317e-01f, 1.422976889e-02f, 9.999679923e-01f, 8.002172224e-03f,
  -4.321779311e-01f, 9.017883539e-01f, 7.418577671e-01f, 6.705572605e-01f, -3.979766965e-01f, 9.173955321e-01f, -3.203544617e-01f, 9.472977519e-01f,
  -1.121525243e-01f, -9.936910272e-01f, -8.499939442e-01f, 5.267924666e-01f, 1.158876270e-01f, 9.932623506e-01f, 6.836758852e-01f, 7.297857404e-01f,
  8.960524797e-01f, 4.439481199e-01f, 9.667292237e-01f, 2.558017969e-01f, 9.894386530e-01f, 1.449523121e-01f, 9.966561794e-01f, 8.170965314e-02f,
  9.989421964e-01f, 4.598378018e-02f, 9.996654391e-01f, 2.586481534e-02f, 9.998942018e-01f, 1.454596408e-02f, 9.999665618e-01f, 8.179994300e-03f,
  -9.923354983e-01f, 1.235731244e-01f, 2.700984478e-01f, 9.628326893e-01f, -6.635380983e-01f, 7.481424809e-01f, -4.828721285e-01f, 8.756908774e-01f,
  -1.238866337e-02f, -9.999232292e-01f, -8.782584071e-01f, 4.781862795e-01f, 8.442521095e-02f, 9.964298010e-01f, 6.705908775e-01f, 7.418273687e-01f,
  8.915683031e-01f, 4.528862834e-01f, 9.652754664e-01f, 2.612340450e-01f, 9.889753461e-01f, 1.480804533e-01f, 9.965093136e-01f, 8.348186314e-02f,
  9.988957047e-01f, 4.698269814e-02f, 9.996507764e-01f, 2.642696537e-02f, 9.998895526e-01f, 1.486215740e-02f, 9.999650717e-01f, 8.357816376e-03f,
  -6.401443481e-01f, -7.682546377e-01f, -2.848462760e-01f, 9.585732222e-01f, -8.632968068e-01f, 5.046966076e-01f, -6.301602125e-01f, 7.764651179e-01f,
  8.749898523e-02f, -9.961646199e-01f, -9.037463665e-01f, 4.280683398e-01f, 5.287837610e-02f, 9.986009598e-01f, 6.572937965e-01f, 7.536344528e-01f,
  8.869948983e-01f, 4.617791772e-01f, 9.637911916e-01f, 2.666580379e-01f, 9.885020852e-01f, 1.512071341e-01f, 9.963592887e-01f, 8.525379747e-02f,
  9.988481998e-01f, 4.798157141e-02f, 9.996357560e-01f, 2.698910609e-02f, 9.998847842e-01f, 1.517834980e-02f, 9.999635816e-01f, 8.535637520e-03f,
  3.005925417e-01f, -9.537526369e-01f, -7.520635128e-01f, 6.590906382e-01f, -9.774428010e-01f, 2.112002373e-01f, -7.575733662e-01f, 6.527500153e-01f,
  1.865123659e-01f, -9.824526310e-01f, -9.263771772e-01f, 3.765970767e-01f, 2.127866633e-02f, 9.997735620e-01f, 6.437888145e-01f, 7.652031779e-01f,
  8.823328614e-01f, 4.706258774e-01f, 9.622764587e-01f, 2.720735967e-01f, 9.880189896e-01f, 1.543322802e-01f, 9.962061048e-01f, 8.702547103e-02f,
  9.987997413e-01f, 4.898039252e-02f, 9.996203780e-01f, 2.755123749e-02f, 9.998799562e-01f, 1.549454033e-02f, 9.999620318e-01f, 8.713458665e-03f,
  9.649659991e-01f, -2.623748481e-01f, -9.876589179e-01f, 1.566201448e-01f, -9.946563840e-01f, -1.032407433e-01f, -8.610929847e-01f, 5.084475279e-01f,
  2.836622000e-01f, -9.589242935e-01f, -9.460792542e-01f, 3.239352107e-01f, -1.034231856e-02f, 9.999465346e-01f, 6.300802827e-01f, 7.765299678e-01f,
  8.775825500e-01f, 4.794255495e-01f, 9.607312679e-01f, 2.774805427e-01f, 9.875259995e-01f, 1.574558914e-01f, 9.960497618e-01f, 8.879686147e-02f,
  9.987502694e-01f, 4.997916892e-02f, 9.996047616e-01f, 2.811336145e-02f, 9.998750091e-01f, 1.581072994e-02f, 9.999604821e-01f, 8.891279809e-03f,
  7.421541810e-01f, 6.702291965e-01f, -9.190733433e-01f, -3.940865099e-01f, -9.132304788e-01f, -4.074434042e-01f, -9.374541640e-01f, 3.481087983e-01f,
  3.779777288e-01f, -9.258146882e-01f, -9.627903700e-01f, 2.702492476e-01f, -4.195296392e-02f, 9.991195798e-01f, 6.161725521e-01f, 7.876111865e-01f,
  8.727445006e-01f, 4.881772399e-01f, 9.591556787e-01f, 2.828786969e-01f, 9.870231748e-01f, 1.605779380e-01f, 9.958902597e-01f, 9.056797624e-02f,
  9.986997843e-01f, 5.097789317e-02f, 9.995887876e-01f, 2.867547609e-02f, 9.998699427e-01f, 1.612691768e-02f, 9.999588728e-01f, 9.069100954e-03f,
  -1.629907787e-01f, 9.866275787e-01f, -5.674299598e-01f, -8.234216571e-01f, -7.412399650e-01f, -6.712401509e-01f, -9.842484593e-01f, 1.767908931e-01f,
  4.685166776e-01f, -8.834546804e-01f, -9.764577150e-01f, 2.157088965e-01f, -7.352165878e-02f, 9.972935915e-01f, 6.020699143e-01f, 7.984433770e-01f,
  8.678191900e-01f, 4.968801439e-01f, 9.575498104e-01f, 2.882679403e-01f, 9.865104556e-01f, 1.636983752e-01f, 9.957276583e-01f, 9.233880043e-02f,
  9.986482859e-01f, 5.197656900e-02f, 9.995725155e-01f, 2.923758142e-02f, 9.998648167e-01f, 1.644310355e-02f, 9.999572635e-01f, 9.246921167e-03f,
  -9.182828069e-01f, 3.959251642e-01f, -4.102845490e-02f, -9.991579652e-01f, -4.957411289e-01f, -8.684703708e-01f, -1.000000000e+00f, -1.029124396e-04f,
  5.543743372e-01f, -8.322674632e-01f, -9.870380163e-01f, 1.604866087e-01f, -1.050168350e-01f, 9.944704175e-01f, 5.877768993e-01f, 8.090230227e-01f,
  8.628070951e-01f, 5.055333376e-01f, 9.559136033e-01f, 2.936480343e-01f, 9.859878421e-01f, 1.668171734e-01f, 9.955618382e-01f, 9.410934150e-02f,
  9.985958338e-01f, 5.297518894e-02f, 9.995558858e-01f, 2.979967743e-02f, 9.998595715e-01f, 1.675928757e-02f, 9.999555945e-01f, 9.424741380e-03f,
  -8.293098211e-01f, -5.587890744e-01f, 4.980090559e-01f, -8.671718240e-01f, -2.010799199e-01f, -9.795748591e-01f, -9.842120409e-01f, -1.769934744e-01f,
  6.346928477e-01f, -7.727645040e-01f, -9.944978356e-01f, 1.047569439e-01f, -1.364070028e-01f, 9.906528592e-01f, 5.732980371e-01f, 8.193469048e-01f,
  8.577086926e-01f, 5.141360164e-01f, 9.542471766e-01f, 2.990188599e-01f, 9.854553938e-01f, 1.699342877e-01f, 9.953929186e-01f, 9.587957710e-02f,
  9.985423684e-01f, 5.397376046e-02f, 9.995389581e-01f, 3.036176413e-02f, 9.998542070e-01f, 1.707546972e-02f, 9.999538660e-01f, 9.602561593e-03f,
  2.212675661e-02f, -9.997551441e-01f, 8.836688399e-01f, -4.681125581e-01f, 1.135222763e-01f, -9.935354590e-01f, -9.373824596e-01f, -3.483017385e-01f,
  7.086697817e-01f, -7.055402994e-01f, -9.988136292e-01f, 4.869610071e-02f, -1.676607877e-01f, 9.858447313e-01f, 5.586379170e-01f, 8.294116259e-01f,
  8.525245190e-01f, 5.226872563e-01f, 9.525505900e-01f, 3.043802381e-01f, 9.849131107e-01f, 1.730497181e-01f, 9.952208400e-01f, 9.764950722e-02f,
  9.984878898e-01f, 5.497227609e-02f, 9.995217323e-01f, 3.092384152e-02f, 9.998487830e-01f, 1.739165001e-02f, 9.999521971e-01f, 9.780380875e-03f,
  8.532201052e-01f, -5.215510130e-01f, 9.971747398e-01f, 7.511685044e-02f, 4.168665409e-01f, -9.089677334e-01f, -8.609883189e-01f, -5.086247325e-01f,
  7.755658627e-01f, -6.312666535e-01f, -9.999717474e-01f, -7.518696599e-03f, -1.987469196e-01f, 9.800508618e-01f, 5.438011289e-01f, 8.392141461e-01f,
  8.472551107e-01f, 5.311862230e-01f, 9.508239031e-01f, 3.097319901e-01f, 9.843609333e-01f, 1.761634201e-01f, 9.950456619e-01f, 9.941913188e-02f,
  9.984323978e-01f, 5.597073585e-02f, 9.995042086e-01f, 3.148590773e-02f, 9.998431802e-01f, 1.770782843e-02f, 9.999504089e-01f, 9.958200157e-03f,
  8.998668194e-01f, 4.361647666e-01f, 8.035689592e-01f, 5.952116251e-01f, 6.788703799e-01f, -7.342581749e-01f, -7.574389577e-01f, -6.529059410e-01f,
  8.347128034e-01f, -5.506855249e-01f, -9.979684949e-01f, -6.370972097e-02f, -2.296343148e-01f, 9.732769728e-01f, 5.287923217e-01f, 8.487512469e-01f,
  8.419010043e-01f, 5.396320224e-01f, 9.490671158e-01f, 3.150739372e-01f, 9.837989211e-01f, 1.792753637e-01f, 9.948672652e-01f, 1.011884436e-01f,
  9.983759522e-01f, 5.696913972e-02f, 9.994863272e-01f, 3.204796836e-02f, 9.998375773e-01f, 1.802400686e-02f, 9.999486208e-01f, 1.013601944e-02f,
  1.191801354e-01f, 9.928726554e-01f, 3.624786139e-01f, 9.319921136e-01f, 8.735510111e-01f, -4.867326319e-01f, -6.300004125e-01f, -7.765948176e-01f,
  8.855195045e-01f, -4.646021724e-01f, -9.928101897e-01f, -1.196993366e-01f, -2.602920830e-01f, 9.655299187e-01f, 5.136163831e-01f, 8.580199480e-01f,
  8.364626765e-01f, 5.480239391e-01f, 9.472803473e-01f, 3.204059303e-01f, 9.832270741e-01f, 1.823855042e-01f, 9.946857691e-01f, 1.029574350e-01f,
  9.983184934e-01f, 5.796748772e-02f, 9.994681478e-01f, 3.261001408e-02f, 9.998317957e-01f, 1.834018156e-02f, 9.999468327e-01f, 1.031383779e-02f,
  -7.710801959e-01f, 6.367380023e-01f, -1.902485639e-01f, 9.817359447e-01f, 9.816020727e-01f, -1.909380853e-01f, -4.826918840e-01f, -8.757902384e-01f,
  9.274784327e-01f, -3.738766611e-01f, -9.845131636e-01f, -1.753105223e-01f, -2.906896174e-01f, 9.568173885e-01f, 4.982779622e-01f, 8.670173287e-01f,
  8.309406638e-01f, 5.563610196e-01f, 9.454635978e-01f, 3.257277906e-01f, 9.826454520e-01f, 1.854938269e-01f, 9.945011139e-01f, 1.047261059e-01f,
  9.982600212e-01f, 5.896577612e-02f, 9.994496703e-01f, 3.317205235e-02f, 9.998259544e-01f, 1.865635626e-02f, 9.999449849e-01f, 1.049165614e-02f,
  -9.524129629e-01f, -3.048106134e-01f, -6.843826175e-01f, 7.291230559e-01f, 9.923082590e-01f, 1.237916648e-01f, -3.201594949e-01f, -9.473636746e-01f,
  9.601702690e-01f, -2.794154882e-01f, -9.731037021e-01f, -2.303674817e-01f, -3.207964599e-01f, 9.471481442e-01f, 4.827820063e-01f, 8.757405877e-01f,
  8.253356218e-01f, 5.646424890e-01f, 9.436169863e-01f, 3.310393393e-01f, 9.820539355e-01f, 1.886002868e-01f, 9.943132997e-01f, 1.064944342e-01f,
  9.982005358e-01f, 5.996400490e-02f, 9.994308352e-01f, 3.373407945e-02f, 9.998199940e-01f, 1.897252724e-02f, 9.999430776e-01f, 1.066947356e-02f,
  -2.581016421e-01f, -9.661177993e-01f, -9.677393436e-01f, 2.519535124e-01f, 9.046077132e-01f, 4.262450635e-01f, -1.475294083e-01f, -9.890576601e-01f,
  9.832684398e-01f, -1.821625084e-01f, -9.586178064e-01f, -2.846961319e-01f, -3.505825400e-01f, 9.365318418e-01f, 4.671333730e-01f, 8.841868639e-01f,
  8.196480274e-01f, 5.728674531e-01f, 9.417404532e-01f, 3.363404274e-01f, 9.814526439e-01f, 1.917048693e-01f, 9.941223264e-01f, 1.082624346e-01f,
  9.981400967e-01f, 6.096217781e-02f, 9.994117022e-01f, 3.429609537e-02f, 9.998139739e-01f, 1.928869821e-02f, 9.999411702e-01f, 1.084729191e-02f,
  6.735071540e-01f, -7.391806841e-01f, -9.530499578e-01f, -3.028131127e-01f, 7.271977663e-01f, 6.864280105e-01f, 2.975366265e-02f, -9.995572567e-01f,
  9.965420961e-01f, -8.308940381e-02f, -9.411013126e-01f, -3.381247520e-01f, -3.800180554e-01f, 9.249790907e-01f, 4.513370395e-01f, 8.923535347e-01f,
  8.138784766e-01f, 5.810351372e-01f, 9.398342371e-01f, 3.416308761e-01f, 9.808415174e-01f, 1.948075294e-01f, 9.939282537e-01f, 1.100300923e-01f,
  9.980786443e-01f, 6.196028739e-02f, 9.993922710e-01f, 3.485810012e-02f, 9.998078346e-01f, 1.960486546e-02f, 9.999392033e-01f, 1.102510933e-02f,
  9.858965874e-01f, 1.673557013e-01f, -6.448385715e-01f, -7.643188238e-01f, 4.776720405e-01f, 8.785382509e-01f, 2.060983181e-01f, -9.785313010e-01f,
  9.998586178e-01f, 1.681390032e-02f, -9.206095338e-01f, -3.904843926e-01f, -4.090735912e-01f, 9.125013947e-01f, 4.353979528e-01f, 9.002380967e-01f,
  8.080275059e-01f, 5.891447663e-01f, 9.378982186e-01f, 3.469105065e-01f, 9.802205563e-01f, 1.979082376e-01f, 9.937310219e-01f, 1.117973998e-01f,
  9.980161786e-01f, 6.295833737e-02f, 9.993724823e-01f, 3.542009369e-02f, 9.998015761e-01f, 1.992103085e-02f, 9.999372363e-01f, 1.120292582e-02f,
};
#define LAS __attribute__((address_space(3)))
typedef unsigned short bf16;
typedef unsigned v4u __attribute__((ext_vector_type(4)));
typedef unsigned v2u __attribute__((ext_vector_type(2)));
typedef float f32x4 __attribute__((ext_vector_type(4)));
typedef float f32x2 __attribute__((ext_vector_type(2)));
typedef float f32x16 __attribute__((ext_vector_type(16)));
typedef short bf16x8 __attribute__((ext_vector_type(8)));
constexpr int NB = 16, SEQ = 4096, CL = 256, ML = NB * SEQ, MC = NB * CL, MT = ML + MC, KVLEN = CL + SEQ;
constexpr int FF = 4096, INW = 1792;
constexpr size_t MiB = 1u << 20;
constexpr size_t WS_MOD = 1 * MiB, WS_ROPE = 3 * MiB, WS_BON = 4 * MiB, WS_CTXS = 14 * MiB,
    WS_W1T = 30 * MiB, WS_W2T = 62 * MiB, WS_WINT = 94 * MiB, WS_WOUTT = 101 * MiB, WS_WOT = 105 * MiB, WS_WRT = 109 * MiB,
    WS_GUPT = 137 * MiB, WS_LUPT = 138 * MiB, WS_GWT = 139 * MiB, WS_A = 140 * MiB, WS_B = 412 * MiB;
constexpr size_t WS_P = WS_B, WS_MIX = WS_B + 238 * MiB, WS_KB = WS_MIX + 136 * MiB, WS_VB = WS_KB + 17 * MiB, WS_HF = WS_VB + 17 * MiB;
constexpr size_t WS_RKV = WS_B, WS_LD = WS_B + 408 * MiB, WS_HID = WS_B, WS_END = 956 * MiB;
constexpr int LDS_BYTES = 147456;
constexpr int NPHASE = 33;
constexpr float C2F = 0.125f * 1.4426950408889634f;

struct Args { const float* in[31]; float* out; unsigned char* ws; int ph_lo, ph_hi; };

__device__ __forceinline__ int opq_tid() { int t = threadIdx.x; asm volatile("" : "+v"(t)); return t; }
__device__ __forceinline__ int opq_bid() { int b = blockIdx.x; asm volatile("" : "+s"(b)); return b; }
__device__ __forceinline__ unsigned char* opq_ptr(unsigned char* p) { asm volatile("" : "+s"(p)); return p; }
__device__ __forceinline__ float bf2f(unsigned short b) { return __uint_as_float((unsigned)b << 16); }
__device__ __forceinline__ unsigned f2bf(float f) { unsigned u = __float_as_uint(f); return (u + 0x7fffu + ((u >> 16) & 1u)) >> 16; }
__device__ __forceinline__ unsigned pk2(float lo, float hi) { unsigned r; asm("v_cvt_pk_bf16_f32 %0, %1, %2" : "=v"(r) : "v"(lo), "v"(hi)); return r; }
__device__ __forceinline__ float sigm(float x) { return 1.0f / (1.0f + __expf(-x)); }
template <int CTRL> __device__ __forceinline__ float dppf(float v) { return __uint_as_float((unsigned)__builtin_amdgcn_update_dpp(0, (int)__float_as_uint(v), CTRL, 0xF, 0xF, true)); }
__device__ __forceinline__ float red8(float v) { v += dppf<0xB1>(v); v += dppf<0x4E>(v); v += dppf<0x141>(v); return v; }
__device__ __forceinline__ float red16(float v) { v = red8(v); v += dppf<0x140>(v); return v; }
__device__ __forceinline__ float wave_sum(float v) {
    v = red16(v);
    const float a = __uint_as_float((unsigned)__builtin_amdgcn_readlane((int)__float_as_uint(v), 0)), b = __uint_as_float((unsigned)__builtin_amdgcn_readlane((int)__float_as_uint(v), 16));
    const float c = __uint_as_float((unsigned)__builtin_amdgcn_readlane((int)__float_as_uint(v), 32)), d = __uint_as_float((unsigned)__builtin_amdgcn_readlane((int)__float_as_uint(v), 48));
    return (a + b) + (c + d);
}
__device__ __forceinline__ int crow16(int r, int hi) { return (r & 3) + 8 * (r >> 2) + 4 * hi; }
__device__ __forceinline__ int rowOf(int d, int b, int p) {
    if (p < CL) { const int j = d ? (CL - 1 - p) : p; return ML + b * CL + j; }
    const int q = p - CL; const int t = d ? (SEQ - 1 - q) : q; return b * SEQ + t;
}

__device__ __forceinline__ void xpose_item(const float* W, int ldn, bf16* WT, int ldk, const float* ksc, int nblk, int item, LAS float* scr, int lane) {
    const int kb = item / nblk, nb = item % nblk, k0 = 64 * kb, n0 = 32 * nb;
#pragma unroll 8
    for (int i = 0; i < 32; ++i) { const int kk = 2 * i + (lane >> 5); float v = W[(size_t)(k0 + kk) * ldn + n0 + (lane & 31)]; if (ksc) v *= ksc[k0 + kk]; scr[kk * 33 + (lane & 31)] = v; }
    asm volatile("s_waitcnt lgkmcnt(0)" ::: "memory");
    const int c = lane & 7;
#pragma unroll
    for (int j = 0; j < 4; ++j) { const int n = (lane >> 3) + 8 * j; const LAS float* s = scr + (8 * c) * 33 + n;
        v4u o; o.x = pk2(s[0 * 33], s[1 * 33]); o.y = pk2(s[2 * 33], s[3 * 33]); o.z = pk2(s[4 * 33], s[5 * 33]); o.w = pk2(s[6 * 33], s[7 * 33]);
        *(v4u*)(WT + (size_t)(n0 + n) * ldk + k0 + 8 * c) = o; }
    asm volatile("s_waitcnt lgkmcnt(0)" ::: "memory");
}

__device__ __forceinline__ void prologue(LAS unsigned char* lds, const Args& a) {
    const int tid = opq_tid(), lane = tid & 63, wave = __builtin_amdgcn_readfirstlane(tid >> 6);
    unsigned char* ws = opq_ptr(a.ws);
    {
        LAS float* sl = (LAS float*)lds; LAS float* red = sl + 1024 * 20;
        float* MOD = (float*)(ws + WS_MOD);
        for (int unit = opq_bid(); unit < 192; unit += gridDim.x) {
            for (int idx = tid; idx < 17 * 1024; idx += 512) { const int mb = idx >> 10, k = idx & 1023; const float cv = mb < 16 ? a.in[1][mb * 1024 + k] : a.in[3][k]; sl[k * 20 + mb] = cv / (1.0f + __expf(-cv)); }
            __syncthreads();
            const int l = unit / 48, n0 = (unit % 48) * 128, col = tid & 127, kq = tid >> 7;
            float acc[17];
#pragma unroll
            for (int j = 0; j < 17; ++j) acc[j] = 0.f;
            const float* wp = a.in[4] + ((size_t)l * 1024 + kq * 256) * 6144 + n0 + col;
#pragma unroll 4
            for (int k = 0; k < 256; ++k) {
                const float w = wp[(size_t)k * 6144]; const LAS float* s = sl + (kq * 256 + k) * 20;
                const f32x4 s0 = *(const LAS f32x4*)s, s1 = *(const LAS f32x4*)(s + 4), s2 = *(const LAS f32x4*)(s + 8), s3 = *(const LAS f32x4*)(s + 12); const float s4 = s[16];
#pragma unroll
                for (int e = 0; e < 4; ++e) { acc[e] += s0[e] * w; acc[4 + e] += s1[e] * w; acc[8 + e] += s2[e] * w; acc[12 + e] += s3[e] * w; }
                acc[16] += s4 * w;
            }
#pragma unroll
            for (int j = 0; j < 17; ++j) red[(kq * 17 + j) * 128 + col] = acc[j];
            __syncthreads();
            for (int idx = tid; idx < 17 * 128; idx += 512) { const int j = idx >> 7, cc = idx & 127;
                const float v = (red[(0 * 17 + j) * 128 + cc] + red[(1 * 17 + j) * 128 + cc]) + (red[(2 * 17 + j) * 128 + cc] + red[(3 * 17 + j) * 128 + cc]) + a.in[5][l * 6144 + n0 + cc];
                MOD[((size_t)l * 17 + j) * 6144 + n0 + cc] = v; }
            __syncthreads();
        }
    }
    {
        LAS float* scr = (LAS float*)(lds + wave * 8704);
        const int gw = opq_bid() * 8 + wave, NGW = gridDim.x * 8;
        bf16* W1T = (bf16*)(ws + WS_W1T); bf16* W2T = (bf16*)(ws + WS_W2T); bf16* WINT = (bf16*)(ws + WS_WINT); bf16* WOUTT = (bf16*)(ws + WS_WOUTT);
        bf16* WOT = (bf16*)(ws + WS_WOT); bf16* WRT = (bf16*)(ws + WS_WRT); bf16* GUPT = (bf16*)(ws + WS_GUPT); bf16* LUPT = (bf16*)(ws + WS_LUPT); bf16* GWT = (bf16*)(ws + WS_GWT);
        const float* mu = a.in[18];
        constexpr int NITEMS = 8192 + 8192 + 1792 + 1024 + 1024 + 6144 + 512 + 256 + 128 + 256 + 128;
        for (int it = gw; it < NITEMS; it += NGW) {
            int r = it;
            if (r < 8192) { const int l = r >> 11, rr = r & 2047; xpose_item(a.in[7] + (size_t)l * 1024 * 4096, 4096, W1T + (size_t)l * 4096 * 1024, 1024, nullptr, 128, rr, scr, lane); continue; } r -= 8192;
            if (r < 8192) { const int l = r >> 11, rr = r & 2047; xpose_item(a.in[8] + (size_t)l * 4096 * 1024, 1024, W2T + (size_t)l * 1024 * 4096, 4096, nullptr, 32, rr, scr, lane); continue; } r -= 8192;
            if (r < 1792) { const int i = r / 896, rr = r % 896; xpose_item(a.in[9] + (size_t)i * 1024 * 1792, 1792, WINT + (size_t)i * 1792 * 1024, 1024, nullptr, 56, rr, scr, lane); continue; } r -= 1792;
            if (r < 1024) { const int i = r >> 9, rr = r & 511; xpose_item(a.in[10] + (size_t)i * 1048576, 1024, WOUTT + (size_t)i * 1048576, 1024, nullptr, 32, rr, scr, lane); continue; } r -= 1024;
            if (r < 1024) { const int i = r >> 9, rr = r & 511; xpose_item(a.in[20] + (size_t)i * 1048576, 1024, WOT + (size_t)i * 1048576, 1024, nullptr, 32, rr, scr, lane); continue; } r -= 1024;
            if (r < 6144) { const int idx = r >> 9, rr = r & 511, half = idx & 1, j = (idx >> 1) % 3, i = idx / 6; const int mi = (j == 0) ? 0 : (j == 1 ? 2 : 3);
                xpose_item(a.in[19] + (size_t)(i * 3 + j) * 1048576, 1024, WRT + (size_t)i * 3584 * 2048 + (size_t)(j * 1024) * 2048 + half * 1024, 2048, half ? mu + (i * 6 + mi) * 1024 : nullptr, 32, rr, scr, lane); continue; } r -= 6144;
            if (r < 512) { const int idx = r >> 5, rr = r & 31, half = idx & 1, kind = (idx >> 1) & 1, d = (idx >> 2) & 1, i = idx >> 3; const int n0 = 3072 + kind * 128 + d * 64;
                xpose_item(a.in[21] + (size_t)((i * 2 + d) * 2 + kind) * 65536, 64, WRT + (size_t)i * 3584 * 2048 + (size_t)n0 * 2048 + half * 1024, 2048, half ? mu + (i * 6 + (kind ? 4 : 1)) * 1024 : nullptr, 2, rr, scr, lane); continue; } r -= 512;
            if (r < 256) { const int idx = r >> 6, rr = r & 63, half = idx & 1, i = idx >> 1;
                xpose_item(a.in[24] + (size_t)i * 131072, 128, WRT + (size_t)i * 3584 * 2048 + (size_t)3328 * 2048 + half * 1024, 2048, half ? mu + (i * 6 + 5) * 1024 : nullptr, 4, rr, scr, lane); continue; } r -= 256;
            if (r < 128) { const int i = r >> 6, rr = r & 63; xpose_item(a.in[25] + (size_t)i * 131072, 1024, GUPT + (size_t)i * 131072, 128, nullptr, 32, rr, scr, lane); continue; } r -= 128;
            if (r < 256) { const int idx = r >> 5, rr = r & 31; xpose_item(a.in[22] + (size_t)idx * 65536, 1024, LUPT + (size_t)idx * 65536, 64, nullptr, 32, rr, scr, lane); continue; } r -= 256;
            { const int idx = r >> 1, rr = r & 1; xpose_item(a.in[15] + (size_t)idx * 4096, 64, GWT + (size_t)idx * 4096, 64, nullptr, 2, rr, scr, lane); }
        }
    }
}

__device__ __forceinline__ void calc_h(const float* xl, const float* xc, int row, const f32x4 (&g)[4], const float* modl, int jsh, int jsc, int lane, f32x4 (&h)[4]) {
    const bool lat = row < ML; const float* xr = lat ? xl + (size_t)row * 1024 : xc + (size_t)(row - ML) * 1024; const int mb = lat ? (row >> 12) : 16;
    f32x4 v[4]; float ss = 0.f;
#pragma unroll
    for (int j = 0; j < 4; ++j) { v[j] = *(const f32x4*)(xr + 4 * lane + 256 * j); ss += (v[j].x * v[j].x + v[j].y * v[j].y) + (v[j].z * v[j].z + v[j].w * v[j].w); }
    ss = wave_sum(ss);
    const float rstd = rsqrtf(ss * (1.0f / 1024.0f) + 1e-6f);
    const float* sh = modl + (size_t)mb * 6144 + jsh * 1024; const float* sc = modl + (size_t)mb * 6144 + jsc * 1024;
#pragma unroll
    for (int j = 0; j < 4; ++j) { const f32x4 s = *(const f32x4*)(sc + 4 * lane + 256 * j), t = *(const f32x4*)(sh + 4 * lane + 256 * j); h[j] = (v[j] * rstd) * g[j] * (s + 1.0f) + t; }
}
template <bool XX> __device__ __forceinline__ void normmod_phase(const float* xl, const float* xc, const float* gvec, const float* modl, int jsh, int jsc, bf16* HA, int pitch, int Mrows) {
    const int tid = opq_tid(), lane = tid & 63, wave = __builtin_amdgcn_readfirstlane(tid >> 6);
    const int gw = opq_bid() * 8 + wave, NGW = gridDim.x * 8, R = (Mrows + NGW - 1) / NGW;
    const int r0 = gw * R, r1 = (r0 + R < Mrows) ? r0 + R : Mrows;
    if (r0 >= r1) return;
    f32x4 g[4];
#pragma unroll
    for (int j = 0; j < 4; ++j) g[j] = *(const f32x4*)(gvec + 4 * lane + 256 * j);
    f32x4 hp[4], hc[4], hn[4];
    calc_h(xl, xc, r0, g, modl, jsh, jsc, lane, hc);
    if (XX) { if (r0 > 0) calc_h(xl, xc, r0 - 1, g, modl, jsh, jsc, lane, hp); else {
#pragma unroll
            for (int j = 0; j < 4; ++j) hp[j] = (f32x4){0.f, 0.f, 0.f, 0.f}; } }
    for (int r = r0; r < r1; ++r) {
        if (XX) { if (r + 1 < MT) calc_h(xl, xc, r + 1, g, modl, jsh, jsc, lane, hn); else {
#pragma unroll
                for (int j = 0; j < 4; ++j) hn[j] = (f32x4){0.f, 0.f, 0.f, 0.f}; } }
        bf16* o = HA + (size_t)r * pitch + 4 * lane;
#pragma unroll
        for (int j = 0; j < 4; ++j) { v2u w; w.x = pk2(hc[j].x, hc[j].y); w.y = pk2(hc[j].z, hc[j].w); *(v2u*)(o + 256 * j) = w; }
        if (XX) {
            const bool lat = r < ML; const int pos = lat ? (r & (SEQ - 1)) : ((r - ML) & (CL - 1)), len = lat ? SEQ : CL;
            const float mp = pos > 0 ? 0.5f : 0.f, mn = pos < len - 1 ? 0.5f : 0.f;
#pragma unroll
            for (int j = 0; j < 4; ++j) { const f32x4 xx = hp[j] * mp + hn[j] * mn - hc[j]; v2u w; w.x = pk2(xx.x, xx.y); w.y = pk2(xx.z, xx.w); *(v2u*)(o + 1024 + 256 * j) = w; }
#pragma unroll
            for (int j = 0; j < 4; ++j) { hp[j] = hc[j]; hc[j] = hn[j]; }
        } else {
            if (r + 1 < r1) calc_h(xl, xc, r + 1, g, modl, jsh, jsc, lane, hc);
        }
    }
}
__device__ __forceinline__ float gelu_tanh(float x) { return 0.5f * x * (1.0f + tanhf(0.7978845608028654f * (x + 0.044715f * x * x * x))); }

__device__ __forceinline__ void even_prep(LAS unsigned char* lds, const Args& a, int i) {
    const int tid = opq_tid(), lane = tid & 63, wave = __builtin_amdgcn_readfirstlane(tid >> 6), hi = lane >> 5, l32 = lane & 31;
    unsigned char* ws = opq_ptr(a.ws);
    const bf16* P = (const bf16*)(ws + WS_P); bf16* MIX = (bf16*)(ws + WS_MIX); bf16* KB = (bf16*)(ws + WS_KB); bf16* VB = (bf16*)(ws + WS_VB); bf16* LAU = (bf16*)(ws + WS_A);
    const bf16* GWT = (const bf16*)(ws + WS_GWT) + (size_t)i * 32 * 4096;
    const f32x2* ROPE = (const f32x2*)ROPE_TAB;
    const float* convw = a.in[13] + i * 4 * 512; const float* convb = a.in[14] + i * 512; const float* gateb = a.in[16] + i * 4 * 512; const float* lam = a.in[17] + i * 2 * 512;
    const float qn = a.in[11][i * 64 + lane], kn = a.in[12][i * 64 + lane];
    LAS float* xcf = (LAS float*)lds + wave * 2048;
    LAS bf16* xcb = (LAS bf16*)(lds + 65536) + wave * (32 * 72);
    const int ch = wave * 64 + lane;
    const float cw0 = convw[0 * 512 + ch], cw1 = convw[1 * 512 + ch], cw2 = convw[2 * 512 + ch], cw3 = convw[3 * 512 + ch], cb = convb[ch];
    for (int unit = opq_bid(); unit < MT / 32; unit += gridDim.x) {
        const int row0 = unit * 32; const bool lat = row0 < ML;
        const int seq0 = lat ? (row0 & ~(SEQ - 1)) : (ML + ((row0 - ML) & ~(CL - 1))), len = lat ? SEQ : CL, t0 = row0 - seq0, b = lat ? (row0 >> 12) : ((row0 - ML) >> 8);
        {
            const bf16* px = P + (size_t)seq0 * INW + 768 + ch;
#define XLD(t) (((t) >= 0 && (t) < len) ? bf2f(px[(size_t)(t) * INW]) : 0.f)
            float xm2 = XLD(t0 - 2), xm1 = XLD(t0 - 1), x0 = XLD(t0);
#pragma unroll 4
            for (int tt = 0; tt < 32; ++tt) {
                const float x1 = XLD(t0 + tt + 1);
                const float xc = cb + xm2 * cw0 + xm1 * cw1 + x0 * cw2 + x1 * cw3;
                xcf[tt * 64 + lane] = xc; xcb[tt * 72 + lane] = (bf16)f2bf(xc);
                xm2 = xm1; xm1 = x0; x0 = x1;
            }
#undef XLD
        }
        __syncthreads();
        {
            bf16x8 afr[4];
#pragma unroll
            for (int ks = 0; ks < 4; ++ks) afr[ks] = *(const LAS bf16x8*)(xcb + l32 * 72 + 16 * ks + 8 * hi);
#pragma unroll 1
            for (int d = 0; d < 2; ++d) {
                f32x16 acc[2][2];
#pragma unroll
                for (int g = 0; g < 2; ++g)
#pragma unroll
                    for (int nh = 0; nh < 2; ++nh) {
                        f32x16 c = {};
                        const bf16* wp = GWT + (size_t)((d * 2 + g) * 8 + wave) * 4096 + (32 * nh + l32) * 64 + 8 * hi;
#pragma unroll
                        for (int ks = 0; ks < 4; ++ks) { const bf16x8 bfr = *(const bf16x8*)(wp + 16 * ks); c = __builtin_amdgcn_mfma_f32_32x32x16_bf16(afr[ks], bfr, c, 0, 0, 0); }
                        acc[g][nh] = c;
                    }
#pragma unroll
                for (int nh = 0; nh < 2; ++nh) {
                    const int e = 32 * nh + l32, chn = wave * 64 + e;
                    const float gb0 = gateb[(d * 2 + 0) * 512 + chn], gb1 = gateb[(d * 2 + 1) * 512 + chn], sp = log1pf(expf(-lam[d * 512 + chn]));
#pragma unroll
                    for (int r = 0; r < 16; ++r) {
                        const int tt = crow16(r, hi);
                        const float rg = sigm(acc[0][nh][r] + gb0), ig = sigm(acc[1][nh][r] + gb1);
                        const float la = -8.0f * rg * sp, xf = xcf[tt * 64 + e];
                        const float u = sqrtf(fmaxf(-expm1f(2.0f * la), 0.f)) * ig * xf;
                        bf16* o = LAU + (size_t)(row0 + tt) * 2048 + d * 512 + chn;
                        o[0] = (bf16)f2bf(la); o[1024] = (bf16)f2bf(u);
                    }
                }
            }
        }
#pragma unroll 2
        for (int tt = 0; tt < 32; ++tt) {
            const int row = row0 + tt, t = t0 + tt; const bf16* pr = P + (size_t)row * INW;
            const float qv = bf2f(pr[wave * 64 + lane]);
            float kvv = 0.f; if (wave < 4) kvv = bf2f(pr[512 + wave * 64 + lane]);
            f32x2 cs = (f32x2){1.f, 0.f}; if (lat) { const int pi = lane >> 1; cs = (pi < 16) ? ROPE[(t >> 6) * 16 + pi] : ROPE[(t & 63) * 16 + (pi - 16)]; }
            float y = qv * rsqrtf(wave_sum(qv * qv) * (1.0f / 64.0f) + 1e-6f) * qn;
            { const float pt = dppf<0xB1>(y); y = (lane & 1) ? (pt * cs.y + y * cs.x) : (y * cs.x - pt * cs.y); }
            MIX[(size_t)row * 1024 + wave * 64 + lane] = (bf16)f2bf(y * C2F);
            const size_t kvrow = (size_t)b * KVLEN + (lat ? (CL + t) : t);
            if (wave < 2) {
                float z = kvv * rsqrtf(wave_sum(kvv * kvv) * (1.0f / 64.0f) + 1e-6f) * kn;
                { const float pt = dppf<0xB1>(z); z = (lane & 1) ? (pt * cs.y + z * cs.x) : (z * cs.x - pt * cs.y); }
                KB[kvrow * 128 + wave * 64 + lane] = (bf16)f2bf(z);
            } else if (wave < 4) {
                VB[kvrow * 128 + (wave - 2) * 64 + lane] = (bf16)f2bf(kvv);
            }
        }
        __syncthreads();
    }
}

__device__ __forceinline__ void rglru_scan(LAS unsigned char* lds, const Args& a) {
    const int tid = opq_tid();
    unsigned char* ws = opq_ptr(a.ws);
    const bf16* P = (const bf16*)(ws + WS_P); bf16* MIX = (bf16*)(ws + WS_MIX); const bf16* LAU = (const bf16*)(ws + WS_A); float* HF = (float*)(ws + WS_HF);
    LAS float* sA = (LAS float*)lds; LAS float* sH = sA + 512;
    for (int unit = opq_bid(); unit < 256; unit += gridDim.x) {
        const int b = unit >> 4, cgp = unit & 15, seg = tid >> 5, chl = tid & 31, ch = cgp * 32 + chl, p0 = seg * 272;
#pragma unroll 1
        for (int d = 0; d < 2; ++d) {
            float A = 1.f, H = 0.f;
#pragma unroll 8
            for (int p = p0; p < p0 + 272; ++p) {
                const size_t row = (size_t)rowOf(d, b, p);
                const float la = bf2f(LAU[row * 2048 + d * 512 + ch]), u = bf2f(LAU[row * 2048 + 1024 + d * 512 + ch]);
                const float av = __expf(la); H = av * H + u; A *= av;
            }
            sA[seg * 32 + chl] = A; sH[seg * 32 + chl] = H;
            __syncthreads();
            float Hc = 0.f;
            for (int s2 = 0; s2 < seg; ++s2) Hc = sA[s2 * 32 + chl] * Hc + sH[s2 * 32 + chl];
            __syncthreads();
            H = Hc;
#pragma unroll 8
            for (int p = p0; p < p0 + 272; ++p) {
                const size_t row = (size_t)rowOf(d, b, p);
                const float la = bf2f(LAU[row * 2048 + d * 512 + ch]), u = bf2f(LAU[row * 2048 + 1024 + d * 512 + ch]);
                const float av = __expf(la); H = av * H + u;
                if (d == 0) HF[row * 512 + ch] = H;
                else { const float tot = H + HF[row * 512 + ch]; const float g = bf2f(P[row * INW + 1280 + ch]); MIX[row * 1024 + 512 + ch] = (bf16)f2bf(gelu_tanh(g) * tot); }
            }
            if (d == 0) { __threadfence(); __syncthreads(); }
        }
    }
    __syncthreads();
}

__device__ __forceinline__ void attention_phase(char* lds_generic, const Args& a) {
    unsigned char* ws = opq_ptr(a.ws);
    const attn_body::bf16* Q = (const attn_body::bf16*)(ws + WS_MIX); const attn_body::bf16* K = (const attn_body::bf16*)(ws + WS_KB); const attn_body::bf16* V = (const attn_body::bf16*)(ws + WS_VB);
    attn_body::bf16* O = (attn_body::bf16*)(ws + WS_MIX);
    for (int it = 0;; ++it) {
        const int U = it * gridDim.x + opq_bid();
        if (U >= 2048 + 128) break;
        if (U < 2048) { const int qb = U & 15, g = (U >> 4) & 3, hk = (U >> 6) & 1, b = U >> 7;
            attn_body::attn_unit<8>((long)b * SEQ + qb * 256, hk * 4 + g, (long)b * KVLEN, KVLEN / 64, Q, K, V, O, lds_generic);
        } else { const int c = U - 2048, h = c & 7, b = c >> 3;
            attn_body::attn_unit<8>((long)ML + b * CL, h, (long)b * KVLEN, CL / 64, Q, K, V, O, lds_generic); }
    }
}

__device__ __forceinline__ void wkv_scan(LAS unsigned char* lds, const Args& a, int i) {
    const int tid = opq_tid(), lane = tid & 63, wave = __builtin_amdgcn_readfirstlane(tid >> 6), hi = lane >> 5, l32 = lane & 31;
    unsigned char* ws = opq_ptr(a.ws);
    const bf16* RKV = (const bf16*)(ws + WS_RKV); const bf16* LD = (const bf16*)(ws + WS_LD);
    bf16* Y0 = (bf16*)(ws + WS_A); bf16* Y1 = Y0 + (size_t)MT * 1024;
    float* BON0 = (float*)(ws + WS_BON); float* BON1 = BON0 + (size_t)MT * 16;
    const bf16* LUPT = (const bf16*)(ws + WS_LUPT) + (size_t)i * 4 * 65536;
    const float* lbias = a.in[23] + i * 4 * 1024;
    const int d = wave >> 2, j = wave & 3, tid_u = tid & 255, sel = j >> 1, nh = j & 1;
    bf16* Yd = d ? Y1 : Y0; float* BONd = d ? BON1 : BON0;
    LAS float* VEC = (LAS float*)(lds + d * 69760); LAS float* VV = VEC + 5 * 2048; LAS float* RAW = VV + 2048; LAS unsigned* YBu = (LAS unsigned*)(RAW + 4096); LAS float* CC = (LAS float*)(YBu + 1024);
    const int rpi = lane >> 3, ks8 = lane & 7, v0 = 16 * j + 2 * rpi;
    for (int unit = opq_bid(); unit < 256; unit += gridDim.x) {
        const int b = unit >> 4, h = unit & 15;
        bf16x8 bfr[4];
#pragma unroll
        for (int ks = 0; ks < 4; ++ks) bfr[ks] = *(const bf16x8*)(LUPT + (size_t)((d * 2 + sel) * 1024 + h * 64 + 32 * nh + l32) * 64 + 16 * ks + 8 * hi);
        const float kkc = a.in[26][i * 1024 + h * 64 + lane], kac = a.in[27][i * 1024 + h * 64 + lane], rkc = a.in[28][i * 1024 + h * 64 + lane];
        const float bw = lbias[(d * 2 + 0) * 1024 + h * 64 + lane], ba = lbias[(d * 2 + 1) * 1024 + h * 64 + lane];
        f32x2 S[8];
#pragma unroll
        for (int e = 0; e < 8; ++e) S[e] = (f32x2){0.f, 0.f};
        bf16x8 afr[4]; unsigned short rr[8], kx[8], vx[8];
#define WKV_LOAD(bt) do { const int p0_ = (bt) * 32; const size_t rowA = (size_t)rowOf(d, b, p0_ + l32); \
            _Pragma("unroll") for (int ks = 0; ks < 4; ++ks) afr[ks] = *(const bf16x8*)(LD + rowA * 512 + sel * 128 + d * 64 + 16 * ks + 8 * hi); \
            _Pragma("unroll") for (int q = 0; q < 8; ++q) { const bf16* pr = RKV + (size_t)rowOf(d, b, p0_ + 8 * j + q) * 3072 + h * 64 + lane; rr[q] = pr[0]; kx[q] = pr[1024]; vx[q] = pr[2048]; } } while (0)
        WKV_LOAD(0);
        constexpr int NBT = KVLEN / 32;
#pragma unroll 1
        for (int bt = 0; bt <= NBT; ++bt) {
            if (bt < NBT) {
                f32x16 c = {};
#pragma unroll
                for (int ks = 0; ks < 4; ++ks) c = __builtin_amdgcn_mfma_f32_32x32x16_bf16(afr[ks], bfr[ks], c, 0, 0, 0);
#pragma unroll
                for (int r = 0; r < 16; ++r) RAW[sel * 2048 + crow16(r, hi) * 64 + 32 * nh + l32] = c[r];
            }
            if (bt > 0) {
                const int tok = tid_u >> 3, c8 = tid_u & 7; const size_t row = (size_t)rowOf(d, b, (bt - 1) * 32 + tok);
                const v4u val = *(const LAS v4u*)(YBu + tok * 32 + c8 * 4);
                *(v4u*)(Yd + row * 1024 + h * 64 + c8 * 8) = val;
            }
            __syncthreads();
            if (bt < NBT) {
#pragma unroll
                for (int q = 0; q < 8; ++q) {
                    const int tok = 8 * j + q;
                    const float r_ = bf2f(rr[q]), k_ = bf2f(kx[q]), v_ = bf2f(vx[q]);
                    const float wv = __expf(-0.6065306597126334f * sigm(RAW[tok * 64 + lane] + bw));
                    const float av = sigm(RAW[2048 + tok * 64 + lane] + ba);
                    const float kk = k_ * kkc;
                    const float kd = k_ * (1.0f + (av - 1.0f) * kac);
                    const float n2 = wave_sum(kk * kk);
                    const float kkn = kk / fmaxf(sqrtf(n2), 1e-12f);
                    const float bv = kkn * av;
                    const float br = wave_sum(bv * r_), cdot = wave_sum(kd * r_), cbn = wave_sum(r_ * kd * rkc);
                    const float rp = wv * r_ - kkn * br;
                    VEC[0 * 2048 + tok * 64 + lane] = kkn; VEC[1 * 2048 + tok * 64 + lane] = rp; VEC[2 * 2048 + tok * 64 + lane] = wv;
                    VEC[3 * 2048 + tok * 64 + lane] = bv; VEC[4 * 2048 + tok * 64 + lane] = kd; VV[tok * 64 + lane] = v_;
                    if (lane == 0) { CC[tok] = cdot; BONd[(size_t)rowOf(d, b, bt * 32 + tok) * 16 + h] = cbn; }
                }
            }
            __syncthreads();
            if (bt + 1 < NBT) WKV_LOAD(bt + 1);
            if (bt < NBT) {
#pragma unroll 2
                for (int s = 0; s < 32; ++s) {
                    const LAS float* vb = VEC + s * 64 + 8 * ks8;
                    const f32x4 ka = *(const LAS f32x4*)(vb), kb2 = *(const LAS f32x4*)(vb + 4);
                    const f32x4 ra = *(const LAS f32x4*)(vb + 2048), rb = *(const LAS f32x4*)(vb + 2048 + 4);
                    const f32x4 wa = *(const LAS f32x4*)(vb + 4096), wb = *(const LAS f32x4*)(vb + 4096 + 4);
                    const f32x4 ba4 = *(const LAS f32x4*)(vb + 6144), bb4 = *(const LAS f32x4*)(vb + 6144 + 4);
                    const f32x4 da = *(const LAS f32x4*)(vb + 8192), db = *(const LAS f32x4*)(vb + 8192 + 4);
                    const f32x2 vv = *(const LAS f32x2*)(VV + s * 64 + v0);
                    const float cc = CC[s];
                    f32x2 sk = (f32x2){0.f, 0.f}, y = (f32x2){0.f, 0.f};
#pragma unroll
                    for (int e = 0; e < 4; ++e) { sk += S[e] * ka[e]; y += S[e] * ra[e]; sk += S[4 + e] * kb2[e]; y += S[4 + e] * rb[e]; }
                    sk.x = red8(sk.x); sk.y = red8(sk.y); y.x = red8(y.x); y.y = red8(y.y);
                    y += vv * cc;
#pragma unroll
                    for (int e = 0; e < 4; ++e) {
                        S[e] = S[e] * wa[e] + (vv * da[e] - sk * ba4[e]);
                        S[4 + e] = S[4 + e] * wb[e] + (vv * db[e] - sk * bb4[e]);
                    }
                    if (ks8 == 0) YBu[(s * 64 + v0) >> 1] = pk2(y.x, y.y);
                }
            }
            __syncthreads();
        }
#undef WKV_LOAD
        __threadfence(); __syncthreads();
        {
            const int c8 = tid & 7, col = h * 64 + c8 * 8;
            float gg[8], gb[8];
#pragma unroll
            for (int e = 0; e < 8; ++e) { gg[e] = a.in[29][i * 1024 + col + e]; gb[e] = a.in[30][i * 1024 + col + e]; }
            for (int it = 0; it < KVLEN / 64; ++it) {
                const int p = it * 64 + (tid >> 3); const size_t row = (size_t)rowOf(0, b, p);
                const v4u a0 = *(const v4u*)(Y0 + row * 1024 + col), a1 = *(const v4u*)(Y1 + row * 1024 + col), vr = *(const v4u*)(RKV + row * 3072 + 2048 + col);
                float y[8], vv[8];
#pragma unroll
                for (int e = 0; e < 4; ++e) { y[2 * e] = __uint_as_float(a0[e] << 16) + __uint_as_float(a1[e] << 16); y[2 * e + 1] = __uint_as_float(a0[e] & 0xffff0000u) + __uint_as_float(a1[e] & 0xffff0000u);
                    vv[2 * e] = __uint_as_float(vr[e] << 16); vv[2 * e + 1] = __uint_as_float(vr[e] & 0xffff0000u); }
                float s = 0.f;
#pragma unroll
                for (int e = 0; e < 8; ++e) s += y[e];
                const float mean = red8(s) * (1.0f / 64.0f);
                float q = 0.f;
#pragma unroll
                for (int e = 0; e < 8; ++e) { y[e] -= mean; q += y[e] * y[e]; }
                const float rstd = rsqrtf(red8(q) * (1.0f / 64.0f) + 64e-5f);
                const float bon = BON0[row * 16 + h] + BON1[row * 16 + h];
                float o[8];
#pragma unroll
                for (int e = 0; e < 8; ++e) o[e] = y[e] * rstd * gg[e] + gb[e] + bon * vv[e];
                v4u w; w.x = pk2(o[0], o[1]); w.y = pk2(o[2], o[3]); w.z = pk2(o[4], o[5]); w.w = pk2(o[6], o[7]);
                *(v4u*)(Y0 + row * 1024 + col) = w;
            }
        }
        __syncthreads();
    }
}
template <class Epi> __device__ __forceinline__ void run_gemm(LAS unsigned char* lds, const bf16* A, int lda, const bf16* Bt, int M, int N, int K, const Epi& E) {
    pg8::Gemm g{A, Bt, M, N, K, lda}; pg8::StaticOrder S; S.init(M, N, (int)gridDim.x, opq_bid());
    pg8::gemm_phase<Epi, pg8::StaticOrder, true, true>(lds, g, S, E);
}

__global__ void __launch_bounds__(512, 2) hybrid_fwd(Args a) {
    extern __shared__ __attribute__((aligned(16))) unsigned char lds_raw[];
    LAS unsigned char* lds = (LAS unsigned char*)lds_raw;
    cg::grid_group grid = cg::this_grid();
    for (int ph = a.ph_lo; ph < a.ph_hi; ++ph) {
        unsigned char* ws = opq_ptr(a.ws);
        float* MOD = (float*)(ws + WS_MOD); float* CTXS = (float*)(ws + WS_CTXS);
        bf16* HA = (bf16*)(ws + WS_A);
        if (ph == 0) { prologue(lds, a); }
        else {
            const int l = (ph - 1) >> 3, s = (ph - 1) & 7, odd = l & 1, i = l >> 1;
            const float* modl = MOD + (size_t)l * 17 * 6144;
            const float* xin_l = (l == 0) ? a.in[0] : a.out; const float* xin_c = (l == 0) ? a.in[2] : CTXS;
            const int Mlate = (l == 3) ? ML : MT;
            int kind = 0; const bf16* A = nullptr; const bf16* Bt = nullptr; int lda = 0, M = MT, N = 0, K = 0; bf16* O = nullptr; int ldc = 0; int gj = 0; const float* ril = a.out; const float* ric = CTXS;
            if (s == 0) {
                if (odd) normmod_phase<true>(xin_l, xin_c, a.in[6] + (l * 2 + 0) * 1024, modl, 0, 1, HA, 2048, MT);
                else normmod_phase<false>(xin_l, xin_c, a.in[6] + (l * 2 + 0) * 1024, modl, 0, 1, HA, 1024, MT);
            } else if (s == 1) {
                if (odd) { kind = 3; A = HA; lda = 2048; Bt = (const bf16*)(ws + WS_WRT) + (size_t)i * 3584 * 2048; N = 3584; K = 2048; O = (bf16*)(ws + WS_RKV); ldc = 3072; }
                else { kind = 1; A = HA; lda = 1024; Bt = (const bf16*)(ws + WS_WINT) + (size_t)i * 1792 * 1024; N = 1792; K = 1024; O = (bf16*)(ws + WS_P); ldc = 1792; }
            } else if (s == 2) {
                if (odd) wkv_scan(lds, a, i); else even_prep(lds, a, i);
            } else if (s == 3) {
                if (odd) { kind = 5; A = (const bf16*)(ws + WS_LD) + 256; lda = 512; Bt = (const bf16*)(ws + WS_GUPT) + (size_t)i * 131072; N = 1024; K = 128; O = HA; M = Mlate; }
                else { rglru_scan(lds, a); attention_phase((char*)lds_raw, a); }
            } else if (s == 4) {
                kind = 4; lda = 1024; N = 1024; K = 1024; gj = 2; M = Mlate; ril = xin_l; ric = xin_c;
                if (odd) { A = HA; Bt = (const bf16*)(ws + WS_WOT) + (size_t)i * 1048576; }
                else { A = (const bf16*)(ws + WS_MIX); Bt = (const bf16*)(ws + WS_WOUTT) + (size_t)i * 1048576; }
            } else if (s == 5) {
                normmod_phase<false>(a.out, CTXS, a.in[6] + (l * 2 + 1) * 1024, modl, 3, 4, HA, 1024, Mlate);
            } else if (s == 6) {
                kind = 2; A = HA; lda = 1024; Bt = (const bf16*)(ws + WS_W1T) + (size_t)l * 4194304; N = 4096; K = 1024; O = (bf16*)(ws + WS_HID); ldc = 4096; M = Mlate;
            } else {
                kind = 4; A = (const bf16*)(ws + WS_HID); lda = 4096; Bt = (const bf16*)(ws + WS_W2T) + (size_t)l * 4194304; N = 1024; K = 4096; gj = 5; M = Mlate;
            }
            if (kind == 1) run_gemm(lds, A, lda, Bt, M, N, K, pg8::EpiStore<0>{O, ldc, nullptr});
            else if (kind == 2) run_gemm(lds, A, lda, Bt, M, N, K, pg8::EpiStore<1>{O, ldc, nullptr});
            else if (kind == 3) run_gemm(lds, A, lda, Bt, M, N, K, pg8::EpiStore<2>{O, ldc, (bf16*)(ws + WS_LD)});
            else if (kind == 4) run_gemm(lds, A, lda, Bt, M, N, K, pg8::EpiResid{ril, ric, a.out, CTXS, modl + gj * 1024});
            else if (kind == 5) run_gemm(lds, A, lda, Bt, M, N, K, pg8::EpiMulInplace{O});
        }
        if (ph + 1 < a.ph_hi) grid.sync();
    }
}

#ifndef MK_MULTI
#define MK_MULTI 0
#endif
extern "C" void kernel_launch(void* const* d_in, const int* in_sizes, int n_in, void* d_out, int out_size, void* d_ws, size_t ws_size, hipStream_t stream) {
    static int grid = 0;
    if (grid == 0) {
        if (n_in != 31 || ws_size < WS_END) { fprintf(stderr, "kernel_launch: unexpected n_in %d / ws %zu\n", n_in, ws_size); grid = -1; return; }
        int dev = 0, cus = 0, per_cu = 0;
        hipGetDevice(&dev); hipDeviceGetAttribute(&cus, hipDeviceAttributeMultiprocessorCount, dev);
        if (hipFuncSetAttribute((const void*)hybrid_fwd, hipFuncAttributeMaxDynamicSharedMemorySize, LDS_BYTES) != hipSuccess) { fprintf(stderr, "kernel_launch: hipFuncSetAttribute failed\n"); }
        if (hipOccupancyMaxActiveBlocksPerMultiprocessor(&per_cu, (const void*)hybrid_fwd, 512, LDS_BYTES) != hipSuccess || per_cu < 1) { fprintf(stderr, "kernel_launch: occupancy query says %d\n", per_cu); per_cu = 1; }
        (void)hipGetLastError();
        grid = cus > 0 ? cus : 256;
    }
    if (grid < 0) return;
    Args a{};
    for (int i = 0; i < 31; ++i) a.in[i] = (const float*)d_in[i];
    a.out = (float*)d_out; a.ws = (unsigned char*)d_ws;
#if MK_MULTI
    for (int ph = 0; ph < NPHASE; ++ph) { a.ph_lo = ph; a.ph_hi = ph + 1; hipLaunchKernelGGL(hybrid_fwd, dim3(grid), dim3(512), LDS_BYTES, stream, a); }
#else
    a.ph_lo = 0; a.ph_hi = NPHASE;
    void* args[] = {&a};
    hipError_t e = hipLaunchCooperativeKernel((const void*)hybrid_fwd, dim3(grid), dim3(512), args, LDS_BYTES, stream);
    if (e != hipSuccess) fprintf(stderr, "cooperative launch failed: %s (grid %d)\n", hipGetErrorString(e), grid);
#endif
}
```
